# Optimizing an MI355X kernel written in HIP

```python
import math
import jax, jax.numpy as jnp
from jax import lax
import numpy as np

D_MODEL = 1024
BATCH = 2
SEQ = 8192
DEPTH = 1
DEC_BATCH = 128
DEC_SEQ = 1
PAST_LEN = 8192
PAGE_SIZE = 128

A_HEADS = 4
A_DK = 128
A_DV = 128
A_WIDTH = A_HEADS * A_DV
A_QKV = 3 * A_WIDTH
CONV_W = 4
CHUNK = 64
B_HEADS = 8
B_KV_HEADS = 2
B_HD = 64
B_GROUP = B_HEADS // B_KV_HEADS
B_WIDTH = B_HEADS * B_HD
B_KV_WIDTH = B_KV_HEADS * B_HD
WINDOW = 128
BLOCK = 128
ROPE_THETA = 10000.0
MIX_WIDTH = A_WIDTH + B_WIDTH

DEEPNORM_ALPHA = (2 * DEPTH) ** 0.25
DEEPNORM_BETA = (8 * DEPTH) ** -0.25
LN_EPS = 1e-5
RMS_EPS = 1e-6
L2_EPS = 1e-6

OFF_A_QKV = 0
OFF_A_Z = OFF_A_QKV + A_QKV
OFF_A_BETA = OFF_A_Z + A_WIDTH
OFF_A_DECAY = OFF_A_BETA + A_HEADS
OFF_B_Q = OFF_A_DECAY + A_HEADS
OFF_B_K = OFF_B_Q + B_WIDTH
OFF_B_V = OFF_B_K + B_KV_WIDTH
OFF_B_Z = OFF_B_V + B_KV_WIDTH
PROJ_COLS = OFF_B_Z + B_WIDTH

kernel_name = "hymba_gdn_swa_sink_decode_step"


def layer_norm(x, g, b):
    xf = x.astype(jnp.float32)
    mu = jnp.mean(xf, -1, keepdims=True)
    var = jnp.mean(jnp.square(xf - mu), -1, keepdims=True)
    return ((xf - mu) * lax.rsqrt(var + LN_EPS) * g.astype(jnp.float32) + b.astype(jnp.float32)).astype(x.dtype)


def rms_norm(x, w):
    xf = x.astype(jnp.float32)
    return xf * lax.rsqrt(jnp.mean(xf * xf, -1, keepdims=True) + RMS_EPS) * w.astype(jnp.float32)


def l2_normalize(x):
    xf = x.astype(jnp.float32)
    return xf * lax.rsqrt(jnp.sum(xf * xf, -1, keepdims=True) + L2_EPS)


def rotary(x, pos):
    half = x.shape[-1] // 2
    inv = 1.0 / (ROPE_THETA ** (jnp.arange(half, dtype=jnp.float32) / half))
    ang = pos.astype(jnp.float32)[:, None] * inv[None, :]
    cos = jnp.cos(ang)[None, :, None, :]
    sin = jnp.sin(ang)[None, :, None, :]
    xf = x.astype(jnp.float32)
    x1, x2 = xf[..., :half], xf[..., half:]
    return jnp.concatenate([x1 * cos - x2 * sin, x2 * cos + x1 * sin], -1)


def causal_conv(buf, u, w):
    xp = jnp.concatenate([buf.astype(u.dtype), u], axis=1)
    t = u.shape[1]
    acc = xp[:, 0:t] * w[0]
    for j in range(1, CONV_W):
        acc = acc + xp[:, j:j + t] * w[j]
    return jax.nn.silu(acc), xp[:, -(CONV_W - 1):]


def gated_delta_chunked(q, k, v, g, beta, s0):
    bsz, t, h, dk = q.shape
    pad = (-t) % CHUNK
    if pad:
        pw4 = ((0, 0), (0, pad), (0, 0), (0, 0))
        pw3 = ((0, 0), (0, pad), (0, 0))
        q, k, v = jnp.pad(q, pw4), jnp.pad(k, pw4), jnp.pad(v, pw4)
        g, beta = jnp.pad(g, pw3), jnp.pad(beta, pw3)
    n = (t + pad) // CHUNK

    def split4(a):
        return a.reshape(bsz, n, CHUNK, h, a.shape[-1]).transpose(1, 0, 3, 2, 4)

    def split3(a):
        return a.reshape(bsz, n, CHUNK, h).transpose(1, 0, 3, 2)

    q, k, v = split4(q), split4(k), split4(v)
    g, beta = split3(g), split3(beta)
    G = jnp.cumsum(g, axis=-1)
    diff = G[..., :, None] - G[..., None, :]
    idx = jnp.arange(CHUNK)
    incl = idx[:, None] >= idx[None, :]
    strict = idx[:, None] > idx[None, :]
    dec_strict = jnp.exp(jnp.where(strict, diff, -jnp.inf))
    dec_incl = jnp.exp(jnp.where(incl, diff, -jnp.inf))
    eye = jnp.eye(CHUNK, dtype=q.dtype)
    lower = eye + beta[..., :, None] * jnp.einsum('nbhtd,nbhid->nbhti', k, k) * dec_strict
    rhs = jnp.concatenate([(beta * jnp.exp(G))[..., None] * k, beta[..., None] * v], -1)
    sol = lax.linalg.triangular_solve(lower, rhs, left_side=True, lower=True, unit_diagonal=True)
    w_mat, u_tilde = sol[..., :dk], sol[..., dk:]
    a_qk = jnp.einsum('nbhtd,nbhid->nbhti', q, k) * dec_incl
    q_dec = jnp.exp(G)[..., None] * q
    k_dec = jnp.exp(G[..., -1:] - G)[..., None] * k
    g_last = jnp.exp(G[..., -1])

    def step(s, xs):
        w_c, ut_c, aqk_c, qd_c, kd_c, gl_c = xs
        u = ut_c - jnp.einsum('bhcd,bhde->bhce', w_c, s)
        o = jnp.einsum('bhcd,bhde->bhce', qd_c, s) + jnp.einsum('bhti,bhie->bhte', aqk_c, u)
        s = gl_c[..., None, None] * s + jnp.einsum('bhcd,bhce->bhde', kd_c, u)
        return s, o

    s_fin, o = lax.scan(step, s0, (w_mat, u_tilde, a_qk, q_dec, k_dec, g_last))
    o = o.transpose(1, 0, 3, 2, 4).reshape(bsz, n * CHUNK, h, v.shape[-1])[:, :t]
    return o, s_fin


def gated_delta_recurrent(q, k, v, g, beta, s0):
    def step(s, xs):
        q_t, k_t, v_t, g_t, b_t = xs
        s = jnp.exp(g_t)[..., None, None] * s
        pred = jnp.einsum('bhd,bhde->bhe', k_t, s)
        s = s + jnp.einsum('bhd,bhe->bhde', k_t, b_t[..., None] * (v_t - pred))
        o = jnp.einsum('bhd,bhde->bhe', q_t, s)
        return s, o

    xs = (q.swapaxes(0, 1), k.swapaxes(0, 1), v.swapaxes(0, 1), g.swapaxes(0, 1), beta.swapaxes(0, 1))
    s_fin, o = lax.scan(step, s0, xs)
    return o.swapaxes(0, 1), s_fin


def sink_softmax(s, mask, sink):
    s = jnp.where(mask, s, -jnp.inf)
    m = jnp.maximum(jnp.max(s, -1, keepdims=True), sink)
    p = jnp.exp(s - m)
    return p / (jnp.sum(p, -1, keepdims=True) + jnp.exp(sink - m))


def swa_prompt(q, k, v, sinks):
    bsz, t = q.shape[:2]
    nb = t // BLOCK
    qb = q.astype(jnp.float32).reshape(bsz, nb, BLOCK, B_KV_HEADS, B_GROUP, B_HD)

    def band(a):
        ab = a.astype(jnp.float32).reshape(bsz, nb, BLOCK, B_KV_HEADS, B_HD)
        prev = jnp.concatenate([jnp.zeros_like(ab[:, :1]), ab[:, :-1]], axis=1)
        return jnp.concatenate([prev, ab], axis=2)

    kb, vb = band(k), band(v)
    s = jnp.einsum('bnqkgd,bnskd->bnkgqs', qb, kb)
    a = jnp.arange(BLOCK)[:, None]
    j = jnp.arange(2 * BLOCK)[None, :]
    rel = a + BLOCK - j
    band_mask = (rel >= 0) & (rel <= WINDOW)
    valid = band_mask[None] & ((jnp.arange(nb)[:, None, None] > 0) | (j[None] >= BLOCK))
    sink = sinks.astype(jnp.float32).reshape(B_KV_HEADS, B_GROUP)[:, :, None, None]
    p = sink_softmax(s, valid[None, :, None, None], sink)
    o = jnp.einsum('bnkgqs,bnskd->bnqkgd', p, vb)
    return o.reshape(bsz, t, B_WIDTH)


def swa_sample(q, k, v, win_k, win_v, sinks):
    bsz, t = q.shape[:2]
    kk = jnp.concatenate([win_k.astype(k.dtype), k], axis=1)
    vv = jnp.concatenate([win_v.astype(v.dtype), v], axis=1)
    qg = q.astype(jnp.float32).reshape(bsz, t, B_KV_HEADS, B_GROUP, B_HD)
    s = jnp.einsum('bqkgd,bskd->bkgqs', qg, kk.astype(jnp.float32))
    a = jnp.arange(t)[:, None]
    j = jnp.arange(WINDOW + t)[None, :]
    rel = WINDOW + a - j
    mask = (rel >= 0) & (rel <= WINDOW)
    sink = sinks.astype(jnp.float32).reshape(B_KV_HEADS, B_GROUP)[:, :, None, None]
    p = sink_softmax(s, mask, sink)
    o = jnp.einsum('bkgqs,bskd->bqkgd', p, vv.astype(jnp.float32))
    return o.reshape(bsz, t, B_WIDTH), kk[:, -WINDOW:], vv[:, -WINDOW:]


def hybrid_layer(x, c, pos, conv_buf, s0, win_k, win_v, is_prompt,
                 w_ada, b_ada, w_in, conv_w, a_log, dt_bias, norm_a, sinks, w_out, ln_g, ln_b):
    bsz, t, _ = x.shape
    mod = (c @ w_ada + b_ada)[:, None, :]
    shift, scale, gate = jnp.split(mod, 3, axis=-1)
    h = x * (1 + scale) + shift
    proj = h @ w_in

    qkv, new_conv = causal_conv(conv_buf, proj[..., OFF_A_QKV:OFF_A_Z], conv_w)
    qa, ka, va = jnp.split(qkv, 3, axis=-1)
    qa = l2_normalize(qa.reshape(bsz, t, A_HEADS, A_DK)) * (A_DK ** -0.5)
    ka = l2_normalize(ka.reshape(bsz, t, A_HEADS, A_DK))
    va = va.reshape(bsz, t, A_HEADS, A_DV).astype(jnp.float32)
    za = proj[..., OFF_A_Z:OFF_A_BETA]
    beta = jax.nn.sigmoid(proj[..., OFF_A_BETA:OFF_A_DECAY].astype(jnp.float32))
    g = -jnp.exp(a_log.astype(jnp.float32)) * jax.nn.softplus(
        proj[..., OFF_A_DECAY:OFF_B_Q].astype(jnp.float32) + dt_bias.astype(jnp.float32))
    s0f = s0.astype(jnp.float32)
    if is_prompt:
        oa, s_new = gated_delta_chunked(qa, ka, va, g, beta, s0f)
    else:
        oa, s_new = gated_delta_recurrent(qa, ka, va, g, beta, s0f)
    oa = rms_norm(oa, norm_a).astype(x.dtype).reshape(bsz, t, A_WIDTH) * jax.nn.silu(za)

    qb = (rotary(proj[..., OFF_B_Q:OFF_B_K].reshape(bsz, t, B_HEADS, B_HD), pos) * (B_HD ** -0.5)).astype(x.dtype)
    kb = rotary(proj[..., OFF_B_K:OFF_B_V].reshape(bsz, t, B_KV_HEADS, B_HD), pos).astype(x.dtype)
    vb = proj[..., OFF_B_V:OFF_B_Z].reshape(bsz, t, B_KV_HEADS, B_HD)
    zb = proj[..., OFF_B_Z:PROJ_COLS]
    if is_prompt:
        ob = swa_prompt(qb, kb, vb, sinks)
        new_k, new_v = kb[:, -WINDOW:], vb[:, -WINDOW:]
    else:
        ob, new_k, new_v = swa_sample(qb, kb, vb, win_k, win_v, sinks)
    ob = ob.astype(x.dtype) * jax.nn.silu(zb)

    mix = jnp.concatenate([oa, ob], axis=-1) @ w_out
    y = layer_norm(DEEPNORM_ALPHA * x + (1 + gate) * mix, ln_g, ln_b)
    return y, new_conv, s_new.astype(s0.dtype), new_k, new_v


def setup_inputs(seed: int = 0) -> dict:
    key = jax.random.key(seed)
    ks = jax.random.split(key, 20)
    f32 = jnp.float32

    def nrm(k, shape, s):
        return jax.random.normal(k, shape, f32) * s

    x_prompt = nrm(ks[0], (BATCH, SEQ, D_MODEL), 1.0)
    x_sample = nrm(ks[1], (DEC_BATCH, DEC_SEQ, D_MODEL), 1.0)
    state_conv = nrm(ks[2], (DEPTH, DEC_BATCH, CONV_W - 1, A_QKV), 1.0)
    state_delta = nrm(ks[3], (DEPTH, DEC_BATCH, A_HEADS, A_DK, A_DV), 0.3)
    cache_swa_k = nrm(ks[4], (DEPTH, DEC_BATCH, WINDOW, B_KV_HEADS, B_HD), 1.0)
    cache_swa_v = nrm(ks[5], (DEPTH, DEC_BATCH, WINDOW, B_KV_HEADS, B_HD), 1.0)
    c_prompt = nrm(ks[6], (BATCH, D_MODEL), 1.0)
    c_sample = nrm(ks[7], (DEC_BATCH, D_MODEL), 1.0)
    w_ada = nrm(ks[8], (DEPTH, D_MODEL, 3 * D_MODEL), 0.1 * D_MODEL ** -0.5)
    b_ada = nrm(ks[9], (DEPTH, 3 * D_MODEL), 0.01)
    col_scale = (jnp.ones((PROJ_COLS,), f32)
                 .at[OFF_A_QKV + 2 * A_WIDTH:OFF_A_Z].set(DEEPNORM_BETA)
                 .at[OFF_B_V:OFF_B_Z].set(DEEPNORM_BETA))
    w_in = nrm(ks[10], (DEPTH, D_MODEL, PROJ_COLS), D_MODEL ** -0.5) * col_scale
    conv_w = nrm(ks[11], (DEPTH, CONV_W, A_QKV), CONV_W ** -0.5)
    a_log = jnp.log(jax.random.uniform(ks[12], (DEPTH, A_HEADS), f32, 1.0, 16.0))
    dt = jnp.exp(jax.random.uniform(ks[13], (DEPTH, A_HEADS), f32, math.log(1e-3), math.log(1e-1)))
    dt_bias = dt + jnp.log(-jnp.expm1(-dt))
    norm_a = 1.0 + nrm(ks[14], (DEPTH, A_DV), 0.05)
    sinks = nrm(ks[15], (DEPTH, B_HEADS), 0.5)
    w_out = nrm(ks[16], (DEPTH, MIX_WIDTH, D_MODEL), MIX_WIDTH ** -0.5 * DEEPNORM_BETA)
    ln_g = 1.0 + nrm(ks[17], (DEPTH, D_MODEL), 0.05)
    ln_b = nrm(ks[18], (DEPTH, D_MODEL), 0.02)
    return {"x_prompt": x_prompt, "x_sample": x_sample,
            "state_conv": state_conv, "state_delta": state_delta,
            "cache_swa_k": cache_swa_k, "cache_swa_v": cache_swa_v,
            "c_prompt": c_prompt, "c_sample": c_sample,
            "w_ada": w_ada, "b_ada": b_ada, "w_in": w_in, "conv_w": conv_w,
            "a_log": a_log, "dt_bias": dt_bias, "norm_a": norm_a, "sinks": sinks,
            "w_out": w_out, "ln_g": ln_g, "ln_b": ln_b}


def reference(x_prompt, x_sample, state_conv, state_delta, cache_swa_k, cache_swa_v,
              c_prompt, c_sample, w_ada, b_ada, w_in, conv_w, a_log, dt_bias, norm_a,
              sinks, w_out, ln_g, ln_b):
    pos_p = jnp.arange(SEQ)
    pos_s = PAST_LEN + jnp.arange(DEC_SEQ)
    yp, ys = x_prompt, x_sample
    conv_p, delta_p, kp_l, vp_l = [], [], [], []
    conv_s, delta_s, ks_l, vs_l = [], [], [], []
    for l in range(DEPTH):
        lp = (w_ada[l], b_ada[l], w_in[l], conv_w[l], a_log[l], dt_bias[l], norm_a[l],
              sinks[l], w_out[l], ln_g[l], ln_b[l])
        zero_conv = jnp.zeros((BATCH, CONV_W - 1, A_QKV), x_prompt.dtype)
        zero_state = jnp.zeros((BATCH, A_HEADS, A_DK, A_DV), x_prompt.dtype)
        yp, cp, sp, kp, vp = hybrid_layer(yp, c_prompt, pos_p, zero_conv, zero_state, None, None, True, *lp)
        ys, cs, ss, kss, vss = hybrid_layer(ys, c_sample, pos_s, state_conv[l], state_delta[l],
                                            cache_swa_k[l], cache_swa_v[l], False, *lp)
        conv_p.append(cp); delta_p.append(sp); kp_l.append(kp); vp_l.append(vp)
        conv_s.append(cs); delta_s.append(ss); ks_l.append(kss); vs_l.append(vss)
    new_conv_p = jnp.stack(conv_p, 0)
    new_delta_p = jnp.stack(delta_p, 0)
    new_swa_k_p = jnp.stack(kp_l, 0)
    new_swa_v_p = jnp.stack(vp_l, 0)
    new_conv_s = jnp.stack(conv_s, 0)
    new_delta_s = jnp.stack(delta_s, 0)
    new_swa_k_s = jnp.stack(ks_l, 0)
    new_swa_v_s = jnp.stack(vs_l, 0)
    return (yp, ys, new_conv_p, new_delta_p, new_swa_k_p, new_swa_v_p,
            new_conv_s, new_delta_s, new_swa_k_s, new_swa_v_s)
```

```cpp
#include <hip/hip_runtime.h>
#include <cstdint>
#include <cstddef>

constexpr int D_MODEL = 1024, BATCH = 2, SEQ = 8192, DEC_BATCH = 128, PAST_LEN = 8192;
constexpr int A_HEADS = 4, A_DK = 128, A_DV = 128, A_WIDTH = 512, A_QKV = 1536, CONV_W = 4;
constexpr int B_HEADS = 8, B_KV_HEADS = 2, B_HD = 64, B_GROUP = 4, B_WIDTH = 512, B_KV_WIDTH = 128, WINDOW = 128;
constexpr int OFF_A_QKV = 0, OFF_A_Z = 1536, OFF_A_BETA = 2048, OFF_A_DECAY = 2052, OFF_B_Q = 2056, OFF_B_K = 2568, OFF_B_V = 2696, OFF_B_Z = 2824, PROJ_COLS = 3336;
constexpr int MP = BATCH * SEQ;
constexpr int MT = MP + DEC_BATCH;
constexpr float LN_EPS = 1e-5f, RMS_EPS = 1e-6f, L2_EPS = 1e-6f;
constexpr float DEEPNORM_ALPHA = 1.189207115002721f;

constexpr size_t O_YP = 0;
constexpr size_t O_YS = O_YP + (size_t)MP * D_MODEL;
constexpr size_t O_CONVP = O_YS + (size_t)DEC_BATCH * D_MODEL;
constexpr size_t O_DELTAP = O_CONVP + (size_t)BATCH * 3 * A_QKV;
constexpr size_t O_KP = O_DELTAP + (size_t)BATCH * A_HEADS * A_DK * A_DV;
constexpr size_t O_VP = O_KP + (size_t)BATCH * WINDOW * B_KV_WIDTH;
constexpr size_t O_CONVS = O_VP + (size_t)BATCH * WINDOW * B_KV_WIDTH;
constexpr size_t O_DELTAS = O_CONVS + (size_t)DEC_BATCH * 3 * A_QKV;
constexpr size_t O_KS = O_DELTAS + (size_t)DEC_BATCH * A_HEADS * A_DK * A_DV;
constexpr size_t O_VS = O_KS + (size_t)DEC_BATCH * WINDOW * B_KV_WIDTH;
constexpr size_t O_END = O_VS + (size_t)DEC_BATCH * WINDOW * B_KV_WIDTH;

typedef unsigned short bf16_t;
__device__ __forceinline__ float bf2f(bf16_t v) { return __uint_as_float(((unsigned)v) << 16); }
__device__ __forceinline__ bf16_t f2bf(float f) { unsigned u = __float_as_uint(f); return (bf16_t)((u + 0x7fffu + ((u >> 16) & 1u)) >> 16); }
__device__ __forceinline__ void stc(float* p, float v) { *p = v; }
__device__ __forceinline__ void stc(bf16_t* p, float v) { *p = f2bf(v); }
__device__ __forceinline__ float siluf(float x) { return x / (1.f + __expf(-x)); }
__device__ __forceinline__ float sigmoidf_(float x) { return 1.f / (1.f + __expf(-x)); }
__device__ __forceinline__ float softplusf_(float x) { return x > 20.f ? x : log1pf(__expf(x)); }

template <typename TC>
__global__ void __launch_bounds__(256) sgemm(const float* __restrict__ A, int lda, const float* __restrict__ B, int ldb, TC* __restrict__ C, int ldc,
                                             int M, int N, int K, const float* __restrict__ bias) {
    __shared__ float As[16][65];
    __shared__ float Bs[16][65];
    const int tx = threadIdx.x & 15, ty = threadIdx.x >> 4;
    const int m0 = blockIdx.y * 64, n0 = blockIdx.x * 64;
    float acc[4][4];
#pragma unroll
    for (int i = 0; i < 4; ++i)
#pragma unroll
        for (int j = 0; j < 4; ++j) acc[i][j] = 0.f;
    for (int k0 = 0; k0 < K; k0 += 16) {
#pragma unroll
        for (int i = 0; i < 4; ++i) {
            const int e = threadIdx.x + i * 256, r = e >> 4, c = e & 15;
            const int gr = m0 + r;
            As[c][r] = gr < M ? A[(size_t)gr * lda + k0 + c] : 0.f;
        }
#pragma unroll
        for (int i = 0; i < 4; ++i) {
            const int e = threadIdx.x + i * 256, r = e >> 6, c = e & 63;
            const int gc = n0 + c;
            Bs[r][c] = gc < N ? B[(size_t)(k0 + r) * ldb + gc] : 0.f;
        }
        __syncthreads();
#pragma unroll
        for (int kk = 0; kk < 16; ++kk) {
            float a[4], b[4];
#pragma unroll
            for (int i = 0; i < 4; ++i) a[i] = As[kk][ty + 16 * i];
#pragma unroll
            for (int j = 0; j < 4; ++j) b[j] = Bs[kk][tx + 16 * j];
#pragma unroll
            for (int i = 0; i < 4; ++i)
#pragma unroll
                for (int j = 0; j < 4; ++j) acc[i][j] = fmaf(a[i], b[j], acc[i][j]);
        }
        __syncthreads();
    }
#pragma unroll
    for (int i = 0; i < 4; ++i) {
        const int gr = m0 + ty + 16 * i;
        if (gr >= M) continue;
#pragma unroll
        for (int j = 0; j < 4; ++j) {
            const int gc = n0 + tx + 16 * j;
            if (gc < N) stc(&C[(size_t)gr * ldc + gc], acc[i][j] + (bias ? bias[gc] : 0.f));
        }
    }
}

__global__ void k_h(const float* __restrict__ xp, const float* __restrict__ xs, const float* __restrict__ mod, float* __restrict__ h) {
    const size_t n = (size_t)MT * D_MODEL;
    for (size_t i = (size_t)blockIdx.x * blockDim.x + threadIdx.x; i < n; i += (size_t)gridDim.x * blockDim.x) {
        const int r = (int)(i / D_MODEL), c = (int)(i % D_MODEL);
        const int mr = r < MP ? r / SEQ : 2 + (r - MP);
        const float x = r < MP ? xp[i] : xs[i - (size_t)MP * D_MODEL];
        const float shift = mod[(size_t)mr * 3072 + c], scale = mod[(size_t)mr * 3072 + 1024 + c];
        h[i] = x * (1.f + scale) + shift;
    }
}

__global__ void __launch_bounds__(128) k_convA(const bf16_t* __restrict__ proj, const float* __restrict__ state_conv, const float* __restrict__ conv_w,
                                               const float* __restrict__ a_log, const float* __restrict__ dt_bias,
                                               float* __restrict__ qa, float* __restrict__ ka, float* __restrict__ va, float* __restrict__ beta, float* __restrict__ g) {
    const int r = blockIdx.x, hd = blockIdx.y, c = threadIdx.x;
    __shared__ float red[2][128];
    float vals[3];
#pragma unroll
    for (int part = 0; part < 3; ++part) {
        const int col = part * A_WIDTH + hd * 128 + c;
        float acc = 0.f;
#pragma unroll
        for (int j = 0; j < 4; ++j) {
            float u;
            if (r < MP) { const int t = r % SEQ, tt = t - 3 + j; u = tt >= 0 ? bf2f(proj[(size_t)(r - 3 + j) * PROJ_COLS + col]) : 0.f; }
            else { const int b = r - MP; u = j < 3 ? state_conv[((size_t)b * 3 + j) * A_QKV + col] : bf2f(proj[(size_t)r * PROJ_COLS + col]); }
            acc = fmaf(u, conv_w[j * A_QKV + col], acc);
        }
        vals[part] = siluf(acc);
    }
    red[0][c] = vals[0] * vals[0]; red[1][c] = vals[1] * vals[1];
    __syncthreads();
    for (int s = 64; s > 0; s >>= 1) { if (c < s) { red[0][c] += red[0][c + s]; red[1][c] += red[1][c + s]; } __syncthreads(); }
    const float rq = rsqrtf(red[0][0] + L2_EPS) * 0.08838834764831845f, rk = rsqrtf(red[1][0] + L2_EPS);
    const size_t o = (size_t)r * A_WIDTH + hd * 128 + c;
    qa[o] = vals[0] * rq; ka[o] = vals[1] * rk; va[o] = vals[2];
    if (c == 0) {
        beta[(size_t)r * 4 + hd] = sigmoidf_(bf2f(proj[(size_t)r * PROJ_COLS + OFF_A_BETA + hd]));
        g[(size_t)r * 4 + hd] = -__expf(a_log[hd]) * softplusf_(bf2f(proj[(size_t)r * PROJ_COLS + OFF_A_DECAY + hd]) + dt_bias[hd]);
    }
}

__global__ void k_conv_state(const bf16_t* __restrict__ proj, const float* __restrict__ state_conv, float* __restrict__ out) {
    const int i = blockIdx.x * blockDim.x + threadIdx.x;
    if (i < BATCH * 3 * A_QKV) { const int b = i / (3 * A_QKV), j = (i / A_QKV) % 3, c = i % A_QKV; out[O_CONVP + i] = bf2f(proj[(size_t)(b * SEQ + SEQ - 3 + j) * PROJ_COLS + c]); }
    if (i < DEC_BATCH * 3 * A_QKV) { const int b = i / (3 * A_QKV), j = (i / A_QKV) % 3, c = i % A_QKV;
        out[O_CONVS + i] = j < 2 ? state_conv[((size_t)b * 3 + j + 1) * A_QKV + c] : bf2f(proj[(size_t)(MP + b) * PROJ_COLS + c]); }
}

__global__ void __launch_bounds__(128) k_delta_rec(const float* __restrict__ qa, const float* __restrict__ ka, const float* __restrict__ va, const float* __restrict__ beta, const float* __restrict__ g,
                                                   const float* __restrict__ s0, float* __restrict__ s_out, float* __restrict__ oa, int row0, int T) {
    const int seq = blockIdx.x >> 2, hd = blockIdx.x & 3, e = threadIdx.x;
    __shared__ float kq[2][128];
    float S[128];
    const size_t sbase = ((size_t)(seq * 4 + hd) * 128) * 128 + e;
#pragma unroll
    for (int d = 0; d < 128; ++d) S[d] = s0 ? s0[sbase + (size_t)d * 128] : 0.f;
    for (int t = 0; t < T; ++t) {
        const size_t r = (size_t)row0 + (size_t)seq * T + t;
        __syncthreads();
        kq[0][e] = ka[r * A_WIDTH + hd * 128 + e]; kq[1][e] = qa[r * A_WIDTH + hd * 128 + e];
        __syncthreads();
        const float dec = __expf(g[r * 4 + hd]), bt = beta[r * 4 + hd], v = va[r * A_WIDTH + hd * 128 + e];
        float pred = 0.f;
#pragma unroll
        for (int d = 0; d < 128; ++d) { S[d] *= dec; pred = fmaf(kq[0][d], S[d], pred); }
        const float u = bt * (v - pred);
        float o = 0.f;
#pragma unroll
        for (int d = 0; d < 128; ++d) { S[d] = fmaf(kq[0][d], u, S[d]); o = fmaf(kq[1][d], S[d], o); }
        oa[r * A_WIDTH + hd * 128 + e] = o;
    }
#pragma unroll
    for (int d = 0; d < 128; ++d) s_out[sbase + (size_t)d * 128] = S[d];
}

__global__ void __launch_bounds__(128) k_rms_gate(const float* __restrict__ oa, const bf16_t* __restrict__ proj, const float* __restrict__ norm_a, float* __restrict__ mix) {
    const int r = blockIdx.x, hd = blockIdx.y, e = threadIdx.x;
    __shared__ float red[128];
    const float o = oa[(size_t)r * A_WIDTH + hd * 128 + e];
    red[e] = o * o; __syncthreads();
    for (int s = 64; s > 0; s >>= 1) { if (e < s) red[e] += red[e + s]; __syncthreads(); }
    const float rs = rsqrtf(red[0] * (1.f / 128.f) + RMS_EPS);
    const float z = bf2f(proj[(size_t)r * PROJ_COLS + OFF_A_Z + hd * 128 + e]);
    mix[(size_t)r * 1024 + hd * 128 + e] = o * rs * norm_a[e] * siluf(z);
}

__device__ __forceinline__ void rope_cs(int pos, int i, float& c, float& s) {
    const float inv = 1.0f / powf(10000.0f, (float)i / 32.0f);
    const float ang = (float)pos * inv;
    const double a = (double)ang;
    const double k = rint(a * 0.15915494309189535);
    const double rr = a - k * 6.283185307179586;
    c = (float)cos(rr); s = (float)sin(rr);
}
__global__ void k_rope(const bf16_t* __restrict__ proj, float* __restrict__ qb, float* __restrict__ kb, float* __restrict__ vb) {
    const int r = blockIdx.x;
    const int pos = r < MP ? r % SEQ : PAST_LEN;
    for (int idx = threadIdx.x; idx < 10 * 32; idx += blockDim.x) {
        const int hh = idx >> 5, i = idx & 31;
        float c, s; rope_cs(pos, i, c, s);
        if (hh < 8) {
            const float x1 = bf2f(proj[(size_t)r * PROJ_COLS + OFF_B_Q + hh * 64 + i]), x2 = bf2f(proj[(size_t)r * PROJ_COLS + OFF_B_Q + hh * 64 + 32 + i]);
            qb[(size_t)r * 512 + hh * 64 + i] = (x1 * c - x2 * s) * 0.125f; qb[(size_t)r * 512 + hh * 64 + 32 + i] = (x2 * c + x1 * s) * 0.125f;
        } else {
            const int kh = hh - 8;
            const float x1 = bf2f(proj[(size_t)r * PROJ_COLS + OFF_B_K + kh * 64 + i]), x2 = bf2f(proj[(size_t)r * PROJ_COLS + OFF_B_K + kh * 64 + 32 + i]);
            kb[(size_t)r * 128 + kh * 64 + i] = x1 * c - x2 * s; kb[(size_t)r * 128 + kh * 64 + 32 + i] = x2 * c + x1 * s;
        }
    }
    for (int idx = threadIdx.x; idx < 128; idx += blockDim.x) vb[(size_t)r * 128 + idx] = bf2f(proj[(size_t)r * PROJ_COLS + OFF_B_V + idx]);
}
__global__ void k_cache_out(const float* __restrict__ kb, const float* __restrict__ vb, const float* __restrict__ ck, const float* __restrict__ cv, float* __restrict__ out) {
    const int i = blockIdx.x * blockDim.x + threadIdx.x;
    if (i < BATCH * WINDOW * 128) { const int b = i / (WINDOW * 128), w = (i / 128) % WINDOW, c = i % 128; const size_t r = (size_t)b * SEQ + SEQ - WINDOW + w;
        out[O_KP + i] = kb[r * 128 + c]; out[O_VP + i] = vb[r * 128 + c]; }
    if (i < DEC_BATCH * WINDOW * 128) { const int b = i / (WINDOW * 128), w = (i / 128) % WINDOW, c = i % 128;
        out[O_KS + i] = w < WINDOW - 1 ? ck[((size_t)b * WINDOW + w + 1) * 128 + c] : kb[(size_t)(MP + b) * 128 + c];
        out[O_VS + i] = w < WINDOW - 1 ? cv[((size_t)b * WINDOW + w + 1) * 128 + c] : vb[(size_t)(MP + b) * 128 + c]; }
}

__global__ void __launch_bounds__(64) k_swa(const float* __restrict__ qb, const float* __restrict__ kb, const float* __restrict__ vb, const float* __restrict__ ck, const float* __restrict__ cv,
                                           const float* __restrict__ sinks, const bf16_t* __restrict__ proj, float* __restrict__ mix) {
    const int r = blockIdx.x, hh = blockIdx.y, kvh = hh >> 2, lane = threadIdx.x;
    __shared__ float qs[64];
    __shared__ float ps[192];
    qs[lane] = qb[(size_t)r * 512 + hh * 64 + lane];
    __syncthreads();
    int nk;
    const bool prompt = r < MP;
    int t = 0, b = 0;
    if (prompt) { t = r % SEQ; b = r / SEQ; nk = t < WINDOW ? t + 1 : WINDOW + 1; } else { b = r - MP; nk = WINDOW + 1; }
    float sc[3]; float mx = -INFINITY;
#pragma unroll
    for (int i = 0; i < 3; ++i) {
        const int j = lane + 64 * i; sc[i] = -INFINITY;
        if (j < nk) {
            const float* kp;
            if (prompt) kp = kb + ((size_t)b * SEQ + (t - nk + 1 + j)) * 128 + kvh * 64;
            else kp = j < WINDOW ? ck + ((size_t)b * WINDOW + j) * 128 + kvh * 64 : kb + (size_t)r * 128 + kvh * 64;
            float a = 0.f;
            for (int d = 0; d < 64; ++d) a = fmaf(qs[d], kp[d], a);
            sc[i] = a; mx = fmaxf(mx, a);
        }
    }
    for (int o = 32; o > 0; o >>= 1) mx = fmaxf(mx, __shfl_xor(mx, o));
    const float sink = sinks[hh];
    mx = fmaxf(mx, sink);
    float sum = 0.f;
#pragma unroll
    for (int i = 0; i < 3; ++i) { const int j = lane + 64 * i; if (j < nk) { const float p = __expf(sc[i] - mx); ps[j] = p; sum += p; } }
    for (int o = 32; o > 0; o >>= 1) sum += __shfl_xor(sum, o);
    sum += __expf(sink - mx);
    __syncthreads();
    float acc = 0.f;
    for (int j = 0; j < nk; ++j) {
        const float* vp;
        if (prompt) vp = vb + ((size_t)b * SEQ + (t - nk + 1 + j)) * 128 + kvh * 64;
        else vp = j < WINDOW ? cv + ((size_t)b * WINDOW + j) * 128 + kvh * 64 : vb + (size_t)r * 128 + kvh * 64;
        acc = fmaf(ps[j], vp[lane], acc);
    }
    const float z = bf2f(proj[(size_t)r * PROJ_COLS + OFF_B_Z + hh * 64 + lane]);
    mix[(size_t)r * 1024 + 512 + hh * 64 + lane] = acc / sum * siluf(z);
}

__global__ void __launch_bounds__(256) k_ln(const float* __restrict__ xp, const float* __restrict__ xs, const float* __restrict__ mod, const float* __restrict__ pre,
                                            const float* __restrict__ ln_g, const float* __restrict__ ln_b, float* __restrict__ out) {
    const int r = blockIdx.x, tid = threadIdx.x;
    const int mr = r < MP ? r / SEQ : 2 + (r - MP);
    const float* x = r < MP ? xp + (size_t)r * D_MODEL : xs + (size_t)(r - MP) * D_MODEL;
    float* y = r < MP ? out + O_YP + (size_t)r * D_MODEL : out + O_YS + (size_t)(r - MP) * D_MODEL;
    __shared__ float red[256];
    float v[4]; float s = 0.f;
#pragma unroll
    for (int i = 0; i < 4; ++i) { const int c = tid + 256 * i; v[i] = DEEPNORM_ALPHA * x[c] + (1.f + mod[(size_t)mr * 3072 + 2048 + c]) * pre[(size_t)r * D_MODEL + c]; s += v[i]; }
    red[tid] = s; __syncthreads();
    for (int o = 128; o > 0; o >>= 1) { if (tid < o) red[tid] += red[tid + o]; __syncthreads(); }
    const float mean = red[0] * (1.f / 1024.f); __syncthreads();
    float q = 0.f;
#pragma unroll
    for (int i = 0; i < 4; ++i) { v[i] -= mean; q += v[i] * v[i]; }
    red[tid] = q; __syncthreads();
    for (int o = 128; o > 0; o >>= 1) { if (tid < o) red[tid] += red[tid + o]; __syncthreads(); }
    const float rstd = rsqrtf(red[0] * (1.f / 1024.f) + LN_EPS);
#pragma unroll
    for (int i = 0; i < 4; ++i) { const int c = tid + 256 * i; y[c] = v[i] * rstd * ln_g[c] + ln_b[c]; }
}

extern "C" void kernel_launch(void* const* d_in, const int* in_sizes, int n_in, void* d_out, int out_size, void* d_ws, size_t ws_size, hipStream_t stream) {
    const float* x_prompt = (const float*)d_in[0]; const float* x_sample = (const float*)d_in[1];
    const float* state_conv = (const float*)d_in[2]; const float* state_delta = (const float*)d_in[3];
    const float* cache_k = (const float*)d_in[4]; const float* cache_v = (const float*)d_in[5];
    const float* c_prompt = (const float*)d_in[6]; const float* c_sample = (const float*)d_in[7];
    const float* w_ada = (const float*)d_in[8]; const float* b_ada = (const float*)d_in[9]; const float* w_in = (const float*)d_in[10];
    const float* conv_w = (const float*)d_in[11]; const float* a_log = (const float*)d_in[12]; const float* dt_bias = (const float*)d_in[13];
    const float* norm_a = (const float*)d_in[14]; const float* sinks = (const float*)d_in[15]; const float* w_out = (const float*)d_in[16];
    const float* ln_g = (const float*)d_in[17]; const float* ln_b = (const float*)d_in[18];
    float* out = (float*)d_out;
    float* ws = (float*)d_ws;
    size_t off = 0;
    auto carve = [&](size_t n) { float* p = ws + off; off += (n + 63) & ~(size_t)63; return p; };
    float* mod = carve((size_t)130 * 3072);
    float* beta = carve((size_t)MT * 4); float* g = carve((size_t)MT * 4);
    bf16_t* proj = (bf16_t*)carve((size_t)MT * PROJ_COLS / 2);
    float* R1 = carve((size_t)MT * 512); float* R2 = carve((size_t)MT * 512); float* R3 = carve((size_t)MT * 512);
    float* h = out; float* mix = out;
    float *qa = R1, *oa = R1, *ka = R2, *qb = R2, *va = R3, *kb = R3, *vb = R3 + (size_t)MT * 128;
    float* pre = R1;

    sgemm<float><<<dim3(3072 / 64, 1), 256, 0, stream>>>(c_prompt, 1024, w_ada, 3072, mod, 3072, 2, 3072, 1024, b_ada);
    sgemm<float><<<dim3(3072 / 64, 2), 256, 0, stream>>>(c_sample, 1024, w_ada, 3072, mod + 2 * 3072, 3072, 128, 3072, 1024, b_ada);
    k_h<<<2048, 256, 0, stream>>>(x_prompt, x_sample, mod, h);
    sgemm<bf16_t><<<dim3((PROJ_COLS + 63) / 64, (MT + 63) / 64), 256, 0, stream>>>(h, 1024, w_in, PROJ_COLS, proj, PROJ_COLS, MT, PROJ_COLS, 1024, nullptr);
    k_convA<<<dim3(MT, 4), 128, 0, stream>>>(proj, state_conv, conv_w, a_log, dt_bias, qa, ka, va, beta, g);
    k_conv_state<<<(DEC_BATCH * 3 * A_QKV + 255) / 256, 256, 0, stream>>>(proj, state_conv, out);
    k_delta_rec<<<BATCH * 4, 128, 0, stream>>>(qa, ka, va, beta, g, nullptr, out + O_DELTAP, oa, 0, SEQ);
    k_delta_rec<<<DEC_BATCH * 4, 128, 0, stream>>>(qa, ka, va, beta, g, state_delta, out + O_DELTAS, oa, MP, 1);
    k_rms_gate<<<dim3(MT, 4), 128, 0, stream>>>(oa, proj, norm_a, mix);
    k_rope<<<MT, 128, 0, stream>>>(proj, qb, kb, vb);
    k_cache_out<<<(DEC_BATCH * WINDOW * 128 + 255) / 256, 256, 0, stream>>>(kb, vb, cache_k, cache_v, out);
    k_swa<<<dim3(MT, 8), 64, 0, stream>>>(qb, kb, vb, cache_k, cache_v, sinks, proj, mix);
    sgemm<float><<<dim3(1024 / 64, (MT + 63) / 64), 256, 0, stream>>>(mix, 1024, w_out, 1024, pre, 1024, MT, 1024, 1024, nullptr);
    k_ln<<<MT, 256, 0, stream>>>(x_prompt, x_sample, mod, pre, ln_g, ln_b, out);
}
```

```cpp
#include <hip/hip_runtime.h>
#include <cstdio>
#include <cstdint>
#include <cstddef>

constexpr int D_MODEL = 1024, BATCH = 2, SEQ = 8192, DEC_BATCH = 128, PAST_LEN = 8192;
constexpr int A_HEADS = 4, A_DK = 128, A_DV = 128, A_WIDTH = 512, A_QKV = 1536, CONV_W = 4;
constexpr int B_HEADS = 8, B_KV_HEADS = 2, B_HD = 64, B_GROUP = 4, B_WIDTH = 512, B_KV_WIDTH = 128, WINDOW = 128;
constexpr int OFF_A_QKV = 0, OFF_A_Z = 1536, OFF_A_BETA = 2048, OFF_A_DECAY = 2052, OFF_B_Q = 2056, OFF_B_K = 2568, OFF_B_V = 2696, OFF_B_Z = 2824, PROJ_COLS = 3336;
constexpr int MP = BATCH * SEQ;
constexpr int MT = MP + DEC_BATCH;
constexpr int MPAD = 16640;
constexpr int PLD = 3584;
constexpr float LN_EPS = 1e-5f, RMS_EPS = 1e-6f, L2_EPS = 1e-6f;
constexpr float DEEPNORM_ALPHA = 1.189207115002721f;

constexpr size_t O_YP = 0;
constexpr size_t O_YS = O_YP + (size_t)MP * D_MODEL;
constexpr size_t O_CONVP = O_YS + (size_t)DEC_BATCH * D_MODEL;
constexpr size_t O_DELTAP = O_CONVP + (size_t)BATCH * 3 * A_QKV;
constexpr size_t O_KP = O_DELTAP + (size_t)BATCH * A_HEADS * A_DK * A_DV;
constexpr size_t O_VP = O_KP + (size_t)BATCH * WINDOW * B_KV_WIDTH;
constexpr size_t O_CONVS = O_VP + (size_t)BATCH * WINDOW * B_KV_WIDTH;
constexpr size_t O_DELTAS = O_CONVS + (size_t)DEC_BATCH * 3 * A_QKV;
constexpr size_t O_KS = O_DELTAS + (size_t)DEC_BATCH * A_HEADS * A_DK * A_DV;
constexpr size_t O_VS = O_KS + (size_t)DEC_BATCH * WINDOW * B_KV_WIDTH;
constexpr size_t O_END = O_VS + (size_t)DEC_BATCH * WINDOW * B_KV_WIDTH;

constexpr size_t MiB = 1u << 20;
constexpr size_t WS_CTL = 0, CTL_ZERO_BYTES = 1 * MiB;
constexpr size_t WS_WIN = 2 * MiB;
constexpr size_t WS_WOUT = 10 * MiB;
constexpr size_t WS_MOD = 12 * MiB;
constexpr size_t WS_SLAB = 14 * MiB;
constexpr size_t WS_ROPE = 28 * MiB;
constexpr size_t WS_H = 32 * MiB;
constexpr size_t WS_PROJ = 66 * MiB;
constexpr size_t WS_X = 180 * MiB;
constexpr size_t WS_END = 256 * MiB;
constexpr int CW_BAR = 4096;

typedef unsigned short bf16_t;
typedef float f32x4 __attribute__((ext_vector_type(4)));
typedef unsigned u32x4 __attribute__((ext_vector_type(4)));
typedef unsigned u32x2 __attribute__((ext_vector_type(2)));
typedef short bf16x8 __attribute__((ext_vector_type(8)));
__device__ __forceinline__ float bf2f(bf16_t v) { return __uint_as_float(((unsigned)v) << 16); }
__device__ __forceinline__ bf16_t f2bf(float f) { unsigned u = __float_as_uint(f); return (bf16_t)((u + 0x7fffu + ((u >> 16) & 1u)) >> 16); }
__device__ __forceinline__ unsigned pk2(float lo, float hi) { return (unsigned)f2bf(lo) | ((unsigned)f2bf(hi) << 16); }
__device__ __forceinline__ void stc(float* p, float v) { *p = v; }
__device__ __forceinline__ void stc(bf16_t* p, float v) { *p = f2bf(v); }
__device__ __forceinline__ float siluf(float x) { return x / (1.f + __expf(-x)); }
__device__ __forceinline__ float sigmoidf_(float x) { return 1.f / (1.f + __expf(-x)); }
__device__ __forceinline__ float softplusf_(float x) { return x > 20.f ? x : log1pf(__expf(x)); }
__device__ __forceinline__ void rope_cs(int pos, int i, float& c, float& s) {
    const float inv = 1.0f / powf(10000.0f, (float)i / 32.0f);
    const float ang = (float)pos * inv;
    const double a = (double)ang;
    const double k = rint(a * 0.15915494309189535);
    const double rr = a - k * 6.283185307179586;
    c = (float)cos(rr); s = (float)sin(rr);
}
namespace pg8 {
#define PG8_LAS __attribute__((address_space(3)))
typedef unsigned short bf16_t;
typedef short bf16x8 __attribute__((ext_vector_type(8)));
typedef float f32x4 __attribute__((ext_vector_type(4)));
typedef unsigned u32x4 __attribute__((ext_vector_type(4)));
constexpr int BM = 256, BK = 64, HALF = 128, HTB = HALF * BK * 2  , STAGE_BYTES = 8 * HTB, NXCD = 8, WGM = 8;

__host__ __device__ __forceinline__ int lds_byte(int r, int c) { const int st = (r >> 4) * 2 + (c >> 5), rr = r & 15, cc = c & 31, ob = rr * 64 + cc * 2; return st * 1024 + (ob ^ (((ob >> 9) & 1) << 5)); }
__host__ __device__ __forceinline__ void stage_rc(int b, int& R, int& C) { const int st = b / 1024, sb = b % 1024, swz = sb ^ (((sb >> 9) & 1) << 5); R = (st >> 1) * 16 + swz / 64; C = (st & 1) * 32 + (swz % 64) / 2; }
__host__ __device__ __forceinline__ int perm32(int rho) { const int n = rho >> 4, i = rho & 15; return 8 * (i >> 2) + 4 * n + (i & 3); }

struct Unit { int pm, pn; };
struct Gemm { const bf16_t* A; const bf16_t* Bt; int M, N, K; };

struct StaticOrder {
    int nM, nN, nwg, G, c;
    __host__ __device__ void init(int M, int N, int G_, int c_) { nM = M / BM; nN = N / BM; nwg = nM * nN; G = G_; c = c_; }
    __host__ __device__ bool next(int i, Unit& u) const {
        const long L = (long)i * G + c; if (L >= nwg) return false;
        int wgid = (int)L; { const int q = nwg / NXCD, r = nwg % NXCD, xcd = wgid % NXCD, off = wgid / NXCD; wgid = (xcd < r ? xcd * (q + 1) : r * (q + 1) + (xcd - r) * q) + off; }
        const int nig = WGM * nN, gid = wgid / nig, fm = gid * WGM, gsz = (nM - fm) < WGM ? (nM - fm) : WGM;
        u.pm = fm + ((wgid % nig) % gsz); u.pn = (wgid % nig) / gsz; return true;
    }
    __device__ __forceinline__ void a_ready(const Unit&) const {}
    __device__ __forceinline__ void done(const Unit&) const {}
};

__device__ __forceinline__ unsigned cvt_pk_bf16(float lo, float hi) { unsigned r; asm volatile("v_cvt_pk_bf16_f32 %0, %1, %2" : "=v"(r) : "v"(lo), "v"(hi)); return r; }
typedef float f32x2 __attribute__((ext_vector_type(2)));
__device__ __forceinline__ f32x2 gelu_pk(f32x2 v) {
    const f32x2 av = __builtin_elementwise_abs(v), d = av * 0.2316418882f + 1.0f;
    f32x2 t; t.x = __builtin_amdgcn_rcpf(d.x); t.y = __builtin_amdgcn_rcpf(d.y);
    f32x2 q = t * 0.5307027145f + (-0.7265760135f); q = q * t + 0.7107068705f; q = q * t + (-0.142248368f); q = q * t + 0.127414796f; q = q * t;
    const f32x2 s = (v * v) * (-0.72134752044f);
    f32x2 e; e.x = __builtin_amdgcn_exp2f(s.x); e.y = __builtin_amdgcn_exp2f(s.y);
    const f32x2 m = v * (q * e), r = v - m;
    f32x2 o; o.x = v.x < 0.f ? m.x : r.x; o.y = v.y < 0.f ? m.y : r.y; return o;
}

struct EpiF32 {
    static constexpr bool PERM = false, AFTER_DRAIN = false;
    float* C; int ldc; const float* bias;
    __device__ __forceinline__ void operator()(const f32x4 (&acc)[2][2][4][2], const Unit& u, int wr, int wc, int fr, int fq) const {
        const int row0 = u.pm * BM + wr * 64 + fr, col0 = u.pn * BM + wc * 32 + 4 * fq;
        f32x4 bv[2][2];
#pragma unroll
        for (int bj = 0; bj < 2; ++bj)
#pragma unroll
            for (int n = 0; n < 2; ++n) bv[bj][n] = bias ? *(const f32x4*)(bias + col0 + bj * HALF + n * 16) : (f32x4){0.f, 0.f, 0.f, 0.f};
#pragma unroll
        for (int ai = 0; ai < 2; ++ai)
#pragma unroll
            for (int m = 0; m < 4; ++m) { float* rowp = C + (size_t)(row0 + ai * HALF + m * 16) * ldc + col0;
#pragma unroll
                for (int bj = 0; bj < 2; ++bj)
#pragma unroll
                    for (int n = 0; n < 2; ++n) *(f32x4*)(rowp + bj * HALF + n * 16) = acc[ai][bj][m][n] + bv[bj][n]; }
    }
};
template <int ACT  > struct EpiBf16 {
    static constexpr bool PERM = true, AFTER_DRAIN = false; static_assert(ACT == 0 || ACT == 1, "EpiBf16: ACT is 0 (none) or 1 (gelu_pk)");
    bf16_t* O; int ldc; const float* bias; int split_cols; size_t split_stride; float scale0;
    __device__ __forceinline__ void operator()(const f32x4 (&acc)[2][2][4][2], const Unit& u, int wr, int wc, int fr, int fq) const {
        const int row0 = u.pm * BM + wr * 64 + fr; int colt = u.pn * BM; bf16_t* base = O;
        float sc = 1.f; if (split_cols) { const int t = colt / split_cols; base += (size_t)t * split_stride; colt -= t * split_cols; if (t == 0) sc = scale0; }
        const int col0 = colt + wc * 32 + 8 * fq, bcol0 = u.pn * BM + wc * 32 + 8 * fq;
        f32x4 bv[2][2];
#pragma unroll
        for (int bj = 0; bj < 2; ++bj)
#pragma unroll
            for (int n = 0; n < 2; ++n) bv[bj][n] = bias ? *(const f32x4*)(bias + bcol0 + bj * HALF + 4 * n) : (f32x4){0.f, 0.f, 0.f, 0.f};
#pragma unroll
        for (int ai = 0; ai < 2; ++ai)
#pragma unroll
            for (int m = 0; m < 4; ++m) { bf16_t* rowp = base + (size_t)(row0 + ai * HALF + m * 16) * ldc + col0;
#pragma unroll
                for (int bj = 0; bj < 2; ++bj) { f32x4 v0 = acc[ai][bj][m][0] + bv[bj][0], v1 = acc[ai][bj][m][1] + bv[bj][1];
                    if (ACT == 1) { f32x2 a = gelu_pk((f32x2){v0[0], v0[1]}), b = gelu_pk((f32x2){v0[2], v0[3]}), c = gelu_pk((f32x2){v1[0], v1[1]}), d = gelu_pk((f32x2){v1[2], v1[3]});
                        v0 = (f32x4){a.x, a.y, b.x, b.y}; v1 = (f32x4){c.x, c.y, d.x, d.y}; }
                    v0 = v0 * sc; v1 = v1 * sc; u32x4 w; w.x = cvt_pk_bf16(v0[0], v0[1]); w.y = cvt_pk_bf16(v0[2], v0[3]); w.z = cvt_pk_bf16(v1[0], v1[1]); w.w = cvt_pk_bf16(v1[2], v1[3]);
                    *(u32x4*)(rowp + bj * HALF) = w; } }
    }
};

struct PanelStats {
    unsigned* xbuf;
    unsigned* cnt;
    unsigned* tmo;
    int ntn; float eps;
    unsigned code;
    __device__ __forceinline__ bool run(const f32x4 (&v)[2][2][4][2], const Unit& u, int wr, int wc, int fr, int fq, PG8_LAS unsigned char* lds, int wid, int lane) const {
        typedef float f32x2v __attribute__((ext_vector_type(2)));
        PG8_LAS f32x2v* P = (PG8_LAS f32x2v*)lds;
        PG8_LAS f32x2v* S = (PG8_LAS f32x2v*)(lds + 8192);
        PG8_LAS unsigned* flag = (PG8_LAS unsigned*)(lds + 8192 + 2048);
#pragma unroll
        for (int ai = 0; ai < 2; ++ai)
#pragma unroll
            for (int m = 0; m < 4; ++m) {
                float s = 0.f;
#pragma unroll
                for (int bj = 0; bj < 2; ++bj)
#pragma unroll
                    for (int n = 0; n < 2; ++n) { const f32x4 x = v[ai][bj][m][n]; s += (x[0] + x[1]) + (x[2] + x[3]); }
                s += __shfl_xor(s, 16); s += __shfl_xor(s, 32);
                const float mw = s * (1.0f / 64.0f); float q = 0.f;
#pragma unroll
                for (int bj = 0; bj < 2; ++bj)
#pragma unroll
                    for (int n = 0; n < 2; ++n) { const f32x4 d = v[ai][bj][m][n] - mw; q += (d[0] * d[0] + d[1] * d[1]) + (d[2] * d[2] + d[3] * d[3]); }
                q += __shfl_xor(q, 16); q += __shfl_xor(q, 32);
                if (fq == 0) P[(ai * HALF + wr * 64 + m * 16 + fr) * 4 + wc] = (f32x2v){mw, q};
            }
        asm volatile("s_waitcnt lgkmcnt(0)" ::: "memory"); __builtin_amdgcn_s_barrier(); asm volatile("" ::: "memory");
#if defined(BROKEN_EXCHANGE_NO_WAIT)
#warning BROKEN CONTROL BUILD: the row-statistics exchange does not wait; results are wrong by design
        if (blockIdx.x >= 64) { const long long t0_ = clock64(); while (clock64() - t0_ < 60000) __builtin_amdgcn_s_sleep(8); }
#endif
        const int row = wid * 32 + (lane & 31);
        if (lane < 32) {
            const f32x2v a = P[row * 4 + 0], b = P[row * 4 + 1], c = P[row * 4 + 2], d = P[row * 4 + 3];
            const float mt = (a.x + b.x + c.x + d.x) * 0.25f;
            const float da = a.x - mt, db = b.x - mt, dc = c.x - mt, dd = d.x - mt;
            const float m2 = (a.y + b.y) + (c.y + d.y) + 64.0f * ((da * da + db * db) + (dc * dc + dd * dd));
            unsigned long long* slot = (unsigned long long*)xbuf + ((size_t)(u.pm * BM + row) * 4 + u.pn);
            __hip_atomic_store(slot, ((unsigned long long)__float_as_uint(m2) << 32) | __float_as_uint(mt), __ATOMIC_RELAXED, __HIP_MEMORY_SCOPE_AGENT);
        }
        asm volatile("s_waitcnt vmcnt(0)" ::: "memory");
        if (lane == 0) __hip_atomic_fetch_add(cnt + 64 * u.pm, 1u, __ATOMIC_RELAXED, __HIP_MEMORY_SCOPE_AGENT);
        if (wid == 0) {
            bool dead = false; const unsigned long long t0 = __builtin_amdgcn_s_memrealtime(); const unsigned want = 8u * (unsigned)ntn;
            for (;;) {
#if defined(BROKEN_EXCHANGE_NO_WAIT)
                break;
#endif
                if ((unsigned)__builtin_amdgcn_readfirstlane(__hip_atomic_load(cnt + 64 * u.pm, __ATOMIC_RELAXED, __HIP_MEMORY_SCOPE_AGENT)) >= want) break;
                if (__builtin_amdgcn_s_memrealtime() - t0 > 2000000ull) {
                    if (lane == 0) { unsigned expect = 0u; __hip_atomic_compare_exchange_strong(tmo + 1, &expect, code | (unsigned)(u.pm & 0xff), __ATOMIC_RELAXED, __ATOMIC_RELAXED, __HIP_MEMORY_SCOPE_AGENT);
                                     __hip_atomic_store(tmo, 1u, __ATOMIC_RELAXED, __HIP_MEMORY_SCOPE_AGENT); }
                    dead = true; break; }
                __builtin_amdgcn_s_sleep(2);
            }
            __builtin_amdgcn_fence(__ATOMIC_ACQUIRE, "agent");
            if (lane == 0) flag[0] = dead ? 1u : 0u;
        }
        asm volatile("s_waitcnt vmcnt(0) lgkmcnt(0)" ::: "memory"); __builtin_amdgcn_s_barrier(); asm volatile("" ::: "memory");
        const bool bad = flag[0] != 0u;
        if (lane < 32) {
            const unsigned long long* slot = (const unsigned long long*)xbuf + (size_t)(u.pm * BM + row) * 4; float mt[4], m2[4]; float ms = 0.f;
#pragma unroll
            for (int t = 0; t < 4; ++t) { if (t < ntn) { const unsigned long long w = __hip_atomic_load(slot + t, __ATOMIC_RELAXED, __HIP_MEMORY_SCOPE_AGENT); mt[t] = __uint_as_float((unsigned)w); m2[t] = __uint_as_float((unsigned)(w >> 32)); } else { mt[t] = 0.f; m2[t] = 0.f; } ms += mt[t]; }
            const float mean = ms / (float)ntn; float q = 0.f;
#pragma unroll
            for (int t = 0; t < 4; ++t) if (t < ntn) { const float dm = mt[t] - mean; q += m2[t] + 256.0f * dm * dm; }
            S[row] = (f32x2v){mean, 1.0f / sqrtf(q / (256.0f * (float)ntn) + eps)};
        }
        asm volatile("s_waitcnt lgkmcnt(0)" ::: "memory"); __builtin_amdgcn_s_barrier(); asm volatile("" ::: "memory");
        return bad;
    }
};
struct EpiLnRes {
    static constexpr bool PERM = false, AFTER_DRAIN = true;
    const float* base; float* out; int ldc; const float* bias; PanelStats st; unsigned poison;
    __device__ __forceinline__ void fused(f32x4 (&acc)[2][2][4][2], const Unit& u, int wr, int wc, int fr, int fq, PG8_LAS unsigned char* lds, int wid, int lane) const {
        typedef float f32x2v __attribute__((ext_vector_type(2)));
        const PG8_LAS f32x2v* S = (const PG8_LAS f32x2v*)(lds + 8192);
        const int col0 = u.pn * BM + wc * 32 + 4 * fq;
#pragma unroll
        for (int bj = 0; bj < 2; ++bj)
#pragma unroll
            for (int n = 0; n < 2; ++n) { const f32x4 bv = bias ? *(const f32x4*)(bias + col0 + bj * HALF + n * 16) : (f32x4){0.f, 0.f, 0.f, 0.f};
#pragma unroll
                for (int ai = 0; ai < 2; ++ai)
#pragma unroll
                    for (int m = 0; m < 4; ++m) acc[ai][bj][m][n] += bv; }
        f32x4 pre[4][2][2];
#pragma unroll
        for (int m = 0; m < 4; ++m) { const size_t off = (size_t)(u.pm * BM + wr * 64 + m * 16 + fr) * ldc + col0;
#pragma unroll
            for (int bj = 0; bj < 2; ++bj)
#pragma unroll
                for (int n = 0; n < 2; ++n) pre[m][bj][n] = *(const f32x4*)(base + off + bj * HALF + n * 16); }
        const bool bad = st.run(acc, u, wr, wc, fr, fq, lds, wid, lane) || poison != 0u;
        const float qnan = __builtin_nanf("");
#pragma unroll
        for (int ai = 0; ai < 2; ++ai)
#pragma unroll
            for (int m = 0; m < 4; ++m) { const int r = ai * HALF + wr * 64 + m * 16 + fr; const f32x2v sr = S[r]; const size_t off = (size_t)(u.pm * BM + r) * ldc + col0;
#pragma unroll
                for (int bj = 0; bj < 2; ++bj)
#pragma unroll
                    for (int n = 0; n < 2; ++n) { const f32x4 bs = ai == 0 ? pre[m][bj][n] : *(const f32x4*)(base + off + bj * HALF + n * 16); f32x4 o = bs + (acc[ai][bj][m][n] - sr.x) * sr.y;
                        if (bad) o = (f32x4){qnan, qnan, qnan, qnan}; *(f32x4*)(out + off + bj * HALF + n * 16) = o; }
                if (m & 1) asm volatile("" ::: "memory"); }
    }
};
struct EpiLnResLn {
    static constexpr bool PERM = false, AFTER_DRAIN = true;
    const float* base; float* out; bf16_t* xn; int ldc; const float* bias; PanelStats st1, st2; unsigned poison;
    __device__ __forceinline__ void fused(f32x4 (&acc)[2][2][4][2], const Unit& u, int wr, int wc, int fr, int fq, PG8_LAS unsigned char* lds, int wid, int lane) const {
        typedef float f32x2v __attribute__((ext_vector_type(2))); typedef unsigned u32x2v __attribute__((ext_vector_type(2)));
        const PG8_LAS f32x2v* S = (const PG8_LAS f32x2v*)(lds + 8192);
        const int col0 = u.pn * BM + wc * 32 + 4 * fq;
#pragma unroll
        for (int bj = 0; bj < 2; ++bj)
#pragma unroll
            for (int n = 0; n < 2; ++n) { const f32x4 bv = bias ? *(const f32x4*)(bias + col0 + bj * HALF + n * 16) : (f32x4){0.f, 0.f, 0.f, 0.f};
#pragma unroll
                for (int ai = 0; ai < 2; ++ai)
#pragma unroll
                    for (int m = 0; m < 4; ++m) acc[ai][bj][m][n] += bv; }
        bool bad = st1.run(acc, u, wr, wc, fr, fq, lds, wid, lane) || poison != 0u;
        const float qnan = __builtin_nanf("");
#pragma unroll
        for (int ai = 0; ai < 2; ++ai)
#pragma unroll
            for (int m = 0; m < 4; ++m) { const int r = ai * HALF + wr * 64 + m * 16 + fr; const f32x2v sr = S[r]; const size_t off = (size_t)(u.pm * BM + r) * ldc + col0;
#pragma unroll
                for (int bj = 0; bj < 2; ++bj)
#pragma unroll
                    for (int n = 0; n < 2; ++n) { const f32x4 bs = *(const f32x4*)(base + off + bj * HALF + n * 16); acc[ai][bj][m][n] = bs + (acc[ai][bj][m][n] - sr.x) * sr.y; }
                asm volatile("" : "+v"(acc[ai][0][m][0]), "+v"(acc[ai][0][m][1]), "+v"(acc[ai][1][m][0]), "+v"(acc[ai][1][m][1]));
                if (m & 1) asm volatile("" ::: "memory"); }
        const bool bad1 = bad;
        bad = st2.run(acc, u, wr, wc, fr, fq, lds, wid, lane) || bad;
#pragma unroll
        for (int ai = 0; ai < 2; ++ai)
#pragma unroll
            for (int m = 0; m < 4; ++m) { const int r = ai * HALF + wr * 64 + m * 16 + fr; const f32x2v sr = S[r]; const size_t off = (size_t)(u.pm * BM + r) * ldc + col0;
#pragma unroll
                for (int bj = 0; bj < 2; ++bj)
#pragma unroll
                    for (int n = 0; n < 2; ++n) { const f32x4 x1 = acc[ai][bj][m][n]; *(f32x4*)(out + off + bj * HALF + n * 16) = bad1 ? (f32x4){qnan, qnan, qnan, qnan} : x1;
                        const f32x4 o = (x1 - sr.x) * sr.y; u32x2v w; w.x = cvt_pk_bf16(o[0], o[1]); w.y = cvt_pk_bf16(o[2], o[3]);
                        if (bad) { w.x = 0x7fc07fc0u; w.y = 0x7fc07fc0u; } *(u32x2v*)(xn + off + bj * HALF + n * 16) = w; }
                asm volatile("" ::: "memory"); }
    }
};

template <class Epi, class Sched, bool ALIGN_EPI = false, bool SP2 = false>
__device__ __forceinline__ void gemm_phase(PG8_LAS unsigned char* lds, const Gemm g, const Sched& S, const Epi& E) {
    const int tid = threadIdx.x, wid = __builtin_amdgcn_readfirstlane(tid >> 6), lane = tid & 63, wr = wid >> 2, wc = wid & 3, fr = lane & 15, fq = lane >> 4;
    const int K = g.K, nt = K / BK;
    unsigned voffA[2], voffB[2];
#pragma unroll
    for (int i = 0; i < 2; ++i) { int R, C; stage_rc(tid * 16 + i * 8192, R, C); const int Rb = Epi::PERM ? ((R & ~31) + perm32(R & 31)) : R;
        voffA[i] = (unsigned)(R * K + C) * 2u; voffB[i] = (unsigned)(Rb * K + C) * 2u; }
    const size_t kstep = (size_t)(BK * 2);
    const size_t hstep = (size_t)HALF * K * 2;
    const size_t tstep = 2 * hstep;
    const unsigned ldsw = (unsigned)wid * 1024u;
    const int aoff = lds_byte(wr * 64 + fr, fq * 8), boff = lds_byte(wc * 32 + fr, fq * 8);
#define PG8_SA(b, h) (((b) * 2 + (h)) * HTB)
#define PG8_SB(b, h) ((4 + (b) * 2 + (h)) * HTB)
#define PG8_STAGE(bufoff, gbase, voff) do { _Pragma("unroll") for (int _i = 0; _i < 2; ++_i) \
        __builtin_amdgcn_global_load_lds((const unsigned*)((const char*)(gbase) + (voff)[_i]), (PG8_LAS unsigned*)(lds + (bufoff) + ldsw + _i * 8192), 16, 0, 0); } while (0)
#define PG8_LDA(dst, b, h) do { _Pragma("unroll") for (int m = 0; m < 4; ++m) _Pragma("unroll") for (int k = 0; k < 2; ++k) dst[m][k] = *(const PG8_LAS bf16x8*)(lds + PG8_SA(b, h) + aoff + m * 2048 + k * 1024); } while (0)
#define PG8_LDB(dst, b, h) do { _Pragma("unroll") for (int n = 0; n < 2; ++n) _Pragma("unroll") for (int k = 0; k < 2; ++k) dst[n][k] = *(const PG8_LAS bf16x8*)(lds + PG8_SB(b, h) + boff + n * 2048 + k * 1024); } while (0)
#define PG8_MMA(ai, bj, At, Bt) do { __builtin_amdgcn_s_setprio(1); _Pragma("unroll") for (int m = 0; m < 4; ++m) _Pragma("unroll") for (int n = 0; n < 2; ++n) _Pragma("unroll") for (int k = 0; k < 2; ++k) \
        acc[ai][bj][m][n] = __builtin_amdgcn_mfma_f32_16x16x32_bf16(Bt[n][k], At[m][k], acc[ai][bj][m][n], 0, 0, 0); __builtin_amdgcn_s_setprio(0); } while (0)
#define PG8_WAIT_V(n) asm volatile("s_waitcnt vmcnt(" #n ")" ::: "memory")
#define PG8_WAIT_L(n) asm volatile("s_waitcnt lgkmcnt(" #n ")" ::: "memory")
#define PG8_BAR __builtin_amdgcn_s_barrier()
#define PG8_SCHED __builtin_amdgcn_sched_barrier(0)
    Unit cur, nxt; int ui = 0;
    if (!S.next(0, cur)) return;
    f32x4 acc[2][2][4][2];
#pragma unroll
    for (int a = 0; a < 2; ++a)
#pragma unroll
        for (int b = 0; b < 2; ++b)
#pragma unroll
            for (int m = 0; m < 4; ++m)
#pragma unroll
                for (int n = 0; n < 2; ++n) acc[a][b][m][n] = (f32x4){0.f, 0.f, 0.f, 0.f};
    bf16x8 At[4][2], B0[2][2], B1[2][2];
    const char* cA = (const char*)g.A + (size_t)cur.pm * tstep; const char* cB = (const char*)g.Bt + (size_t)cur.pn * tstep;
    S.a_ready(cur);
    if constexpr (SP2) {
        PG8_STAGE(PG8_SB(0, 0), cB, voffB); PG8_STAGE(PG8_SB(0, 1), cB + hstep, voffB); PG8_STAGE(PG8_SA(0, 0), cA, voffA); PG8_STAGE(PG8_SA(0, 1), cA + hstep, voffA);
        if (wr == 1) PG8_BAR;
        PG8_WAIT_V(2); PG8_BAR;
        PG8_STAGE(PG8_SB(1, 0), cB + kstep, voffB); PG8_STAGE(PG8_SA(1, 0), cA + kstep, voffA); PG8_STAGE(PG8_SB(1, 1), cB + hstep + kstep, voffB);
        PG8_WAIT_V(6); PG8_BAR;
    } else {
        PG8_STAGE(PG8_SB(0, 0), cB, voffB); PG8_STAGE(PG8_SA(0, 0), cA, voffA); PG8_STAGE(PG8_SB(0, 1), cB + hstep, voffB); PG8_STAGE(PG8_SA(0, 1), cA + hstep, voffA);
        if (wr == 1) PG8_BAR;
        PG8_WAIT_V(4); PG8_BAR;
        PG8_STAGE(PG8_SB(1, 0), cB + kstep, voffB); PG8_STAGE(PG8_SA(1, 0), cA + kstep, voffA); PG8_STAGE(PG8_SB(1, 1), cB + hstep + kstep, voffB);
        PG8_WAIT_V(6); PG8_BAR;
    }
    for (;;) {
        const bool has_next = S.next(ui + 1, nxt);
        const char* nA = has_next ? (const char*)g.A + (size_t)nxt.pm * tstep : cA; const char* nB = has_next ? (const char*)g.Bt + (size_t)nxt.pn * tstep : cB;
        for (int t = 0; t < nt; t += 2) {
            const bool last = (t == nt - 2);
            const char* a1 = cA + (size_t)(t + 1) * kstep;
            const char* a2 = last ? nA : cA + (size_t)(t + 2) * kstep; const char* b2 = last ? nB : cB + (size_t)(t + 2) * kstep;
            const char* a3 = a2 + kstep; const char* b3 = b2 + kstep;
            if (last && has_next) S.a_ready(nxt);
            if constexpr (SP2) {
            PG8_LDB(B0, 0, 0); PG8_LDB(B1, 0, 1); PG8_SCHED; PG8_LDA(At, 0, 0); PG8_STAGE(PG8_SA(1, 1), a1 + hstep, voffA);
            PG8_WAIT_V(8); PG8_WAIT_L(0); PG8_BAR; PG8_MMA(0, 0, At, B0); PG8_MMA(0, 1, At, B1); PG8_BAR; PG8_SCHED;
            PG8_LDA(At, 0, 1); PG8_STAGE(PG8_SB(0, 0), b2, voffB); PG8_STAGE(PG8_SB(0, 1), b2 + hstep, voffB); PG8_STAGE(PG8_SA(0, 0), a2, voffA);
            PG8_WAIT_V(8); PG8_WAIT_L(0); PG8_BAR; PG8_MMA(1, 0, At, B0); PG8_MMA(1, 1, At, B1); PG8_BAR; PG8_SCHED;
            PG8_LDB(B0, 1, 0); PG8_LDB(B1, 1, 1); PG8_SCHED; PG8_LDA(At, 1, 0); PG8_STAGE(PG8_SA(0, 1), a2 + hstep, voffA);
            PG8_WAIT_V(8); PG8_WAIT_L(0); PG8_BAR; PG8_MMA(0, 0, At, B0); PG8_MMA(0, 1, At, B1); PG8_BAR; PG8_SCHED;
            PG8_LDA(At, 1, 1); PG8_STAGE(PG8_SB(1, 0), b3, voffB); PG8_STAGE(PG8_SB(1, 1), b3 + hstep, voffB); PG8_STAGE(PG8_SA(1, 0), a3, voffA);
            PG8_WAIT_V(8); PG8_WAIT_L(0); PG8_BAR; PG8_MMA(1, 0, At, B0); PG8_MMA(1, 1, At, B1); PG8_BAR; PG8_SCHED;
            } else {
            PG8_LDB(B0, 0, 0); PG8_SCHED; PG8_LDA(At, 0, 0); PG8_STAGE(PG8_SA(1, 1), a1 + hstep, voffA);
            PG8_WAIT_L(8); PG8_BAR; PG8_WAIT_L(0); PG8_MMA(0, 0, At, B0); PG8_BAR; PG8_SCHED;
            PG8_LDB(B1, 0, 1); PG8_STAGE(PG8_SB(0, 0), b2, voffB);
            PG8_BAR; PG8_WAIT_L(0); PG8_MMA(0, 1, At, B1); PG8_BAR;
            PG8_LDA(At, 0, 1); PG8_STAGE(PG8_SA(0, 0), a2, voffA);
            PG8_BAR; PG8_WAIT_L(0); PG8_MMA(1, 0, At, B0); PG8_BAR; PG8_SCHED;
            PG8_STAGE(PG8_SB(0, 1), b2 + hstep, voffB);
            PG8_WAIT_V(6); PG8_BAR; PG8_MMA(1, 1, At, B1); PG8_BAR;
            PG8_LDB(B0, 1, 0); PG8_SCHED; PG8_LDA(At, 1, 0); PG8_STAGE(PG8_SA(0, 1), a2 + hstep, voffA);
            PG8_WAIT_L(8); PG8_BAR; PG8_WAIT_L(0); PG8_MMA(0, 0, At, B0); PG8_BAR; PG8_SCHED;
            PG8_LDB(B1, 1, 1); PG8_STAGE(PG8_SB(1, 0), b3, voffB);
            PG8_BAR; PG8_WAIT_L(0); PG8_MMA(0, 1, At, B1); PG8_BAR;
            PG8_LDA(At, 1, 1); PG8_STAGE(PG8_SA(1, 0), a3, voffA);
            PG8_BAR; PG8_WAIT_L(0); PG8_MMA(1, 0, At, B0); PG8_BAR; PG8_SCHED;
            PG8_STAGE(PG8_SB(1, 1), b3 + hstep, voffB);
            PG8_WAIT_V(6); PG8_BAR; PG8_MMA(1, 1, At, B1); PG8_BAR;
            }
        }
        if constexpr (ALIGN_EPI) { if (wr == 0) PG8_BAR; }
        if constexpr (!Epi::AFTER_DRAIN) { E(acc, cur, wr, wc, fr, fq); S.done(cur); }
        if (!has_next) break;
#pragma unroll
        for (int a = 0; a < 2; ++a)
#pragma unroll
            for (int b = 0; b < 2; ++b)
#pragma unroll
                for (int m = 0; m < 4; ++m)
#pragma unroll
                    for (int n = 0; n < 2; ++n) acc[a][b][m][n] = (f32x4){0.f, 0.f, 0.f, 0.f};
        cur = nxt; cA = nA; cB = nB; ++ui;
        if constexpr (ALIGN_EPI) { if (wr == 1) PG8_BAR; }
    }
    PG8_WAIT_V(0);
    if constexpr (!ALIGN_EPI) { if (wr == 0) PG8_BAR; }
    PG8_BAR;
    if constexpr (Epi::AFTER_DRAIN) { E.fused(acc, cur, wr, wc, fr, fq, lds, wid, lane); S.done(cur); }
#undef PG8_SA
#undef PG8_SB
#undef PG8_STAGE
#undef PG8_LDA
#undef PG8_LDB
#undef PG8_MMA
#undef PG8_WAIT_V
#undef PG8_WAIT_L
#undef PG8_BAR
#undef PG8_SCHED
}
}
#define GAS __attribute__((address_space(1)))
#define LAS __attribute__((address_space(3)))
typedef GAS unsigned gu32;
#define LDS_WAIT() asm volatile("s_waitcnt lgkmcnt(0)" ::: "memory")
#define VM_WAIT() asm volatile("s_waitcnt vmcnt(0)" ::: "memory")
#define XB_TMO      128
#define XB_XCNT(j)  (256  + 64 * (j))
#define XB_XSUB(j)  (1280 + 64 * (j))
#define XB_XGEN(j)  (2304 + 64 * (j))
#define XB_TOP      3328
#define XB_TOPGEN   3392
#define XCD_BAR_WORDS 3456
#define XB_SPIN_CAP (1u << 18)

__device__ __forceinline__ unsigned xb_ld(unsigned* p)              { return __hip_atomic_load(p, __ATOMIC_RELAXED, __HIP_MEMORY_SCOPE_AGENT); }
__device__ __forceinline__ unsigned xb_add(unsigned* p, unsigned v) { return __hip_atomic_fetch_add(p, v, __ATOMIC_RELAXED, __HIP_MEMORY_SCOPE_AGENT); }
__device__ __forceinline__ unsigned xb_xcc_id() { return (unsigned)__builtin_amdgcn_s_getreg((3 << 11) | 20) & 0xFu; }
#define XB_SPIN(cond, bar) do { unsigned _sp = 0; while (cond) { __builtin_amdgcn_s_sleep(1); \
    if ((++_sp & 255u) == 0u) { if (xb_ld(&(bar)[XB_TMO])) break; if (_sp > XB_SPIN_CAP) { atomicAdd(&(bar)[XB_TMO], 1u); break; } } } } while (0)

struct XcdBarrier {
    unsigned* bar; unsigned x;
    volatile LAS unsigned* st;
};

__device__ __forceinline__ XcdBarrier xcd_barrier_post(unsigned* bar, volatile LAS unsigned* st) {
    XcdBarrier b; b.bar = bar; b.x = xb_xcc_id(); b.st = st;
    if (threadIdx.x == 0) (void)xb_add(&bar[XB_XCNT(b.x)], 1u);
    return b;
}
__device__ __forceinline__ void xcd_barrier_complete(unsigned* bar, unsigned x, unsigned& nloc, unsigned& nx) {
    const unsigned G = gridDim.x * gridDim.y * gridDim.z;
    unsigned sum, cnt, mine, sp = 0u;
    for (;;) {
        sum = 0u; cnt = 0u; mine = 0u;
#pragma unroll
        for (unsigned j = 0; j < 16; ++j) { const unsigned c = xb_ld(&bar[XB_XCNT(j)]); sum += c; cnt += (c > 0u) ? 1u : 0u; mine = (j == x) ? c : mine; }
        if (sum == G) break;
        __builtin_amdgcn_s_sleep(1);
        if ((++sp & 255u) == 0u) { if (xb_ld(&bar[XB_TMO])) break; if (sp > XB_SPIN_CAP) { atomicAdd(&bar[XB_TMO], 1u); break; } }
    }
    nloc = mine > 0u ? mine : 1u; nx = cnt > 0u ? cnt : 1u;
}

__device__ __forceinline__ void xcd_barrier(const XcdBarrier& b) {
    asm volatile("s_waitcnt vmcnt(0)" ::: "memory");
    __syncthreads();
    if (threadIdx.x == 0) {
        unsigned* bar = b.bar;
        __builtin_amdgcn_s_waitcnt(0);
        unsigned nloc = b.st[0], nx = b.st[1];
        if (nloc == 0u) { xcd_barrier_complete(bar, b.x, nloc, nx); b.st[0] = nloc; b.st[1] = nx; }
        const unsigned old = xb_add(&bar[XB_XSUB(b.x)], 1u);
        const unsigned gen = old / nloc;
        if (old + 1u == (gen + 1u) * nloc) {
            __builtin_amdgcn_fence(__ATOMIC_RELEASE, "agent");
            asm volatile("s_waitcnt vmcnt(0)" ::: "memory");
            const unsigned og = xb_add(&bar[XB_TOP], 1u);
            const unsigned tg = og / nx;
            if (og + 1u == (tg + 1u) * nx) xb_add(&bar[XB_TOPGEN], 1u);
            else XB_SPIN(xb_ld(&bar[XB_TOPGEN]) == tg, bar);
            __builtin_amdgcn_fence(__ATOMIC_ACQUIRE, "agent");
            xb_add(&bar[XB_XGEN(b.x)], 1u);
            asm volatile("s_waitcnt vmcnt(0)" ::: "memory");
        } else {
            XB_SPIN(xb_ld(&bar[XB_XGEN(b.x)]) == gen, bar);
            __builtin_amdgcn_fence(__ATOMIC_ACQUIRE, "agent");
            asm volatile("s_waitcnt vmcnt(0)" ::: "memory");
        }
    }
    __syncthreads();
}
constexpr int NWAVES = 8;
constexpr int RING_BYTES = 131072;
constexpr int LDSCTL_OFF = RING_BYTES, MISC_OFF = LDSCTL_OFF + 320;
constexpr int LDS_BYTES = 147456;
struct Args { const float* in[19]; float* out; unsigned char* ws; int ph_lo, ph_hi; };
struct Frame {
    LAS unsigned char* lds; volatile LAS unsigned* MISC; unsigned* ctl;
    int tid, lane, wave, vcu, G;
    const float *x_prompt, *x_sample, *state_conv, *state_delta, *cache_k, *cache_v, *c_prompt, *c_sample, *w_ada, *b_ada, *w_in, *conv_w, *a_log, *dt_bias, *norm_a, *sinks, *w_out, *ln_g, *ln_b;
    float* out; unsigned char* ws;
};
__device__ __forceinline__ float wave_sum(float v) {
#pragma unroll
    for (int o = 1; o < 64; o <<= 1) v += __shfl_xor(v, o);
    return v;
}
__device__ __forceinline__ void p0_transpose_item(const float* W, int K, int N, int nblk, bf16_t* WT, LAS float* scr, int item, int lane) {
    const int kb = item / nblk, nb = item % nblk, k0 = 64 * kb, n0 = 32 * nb;
    const int nsrc = n0 + (lane & 31);
#pragma unroll 8
    for (int i = 0; i < 32; ++i) { const int kk = 2 * i + (lane >> 5); scr[kk * 33 + (lane & 31)] = nsrc < N ? W[(size_t)(k0 + kk) * N + nsrc] : 0.f; }
    LDS_WAIT(); asm volatile("" ::: "memory");
    const int c = lane & 7;
#pragma unroll
    for (int j = 0; j < 4; ++j) { const int n = (lane >> 3) + 8 * j; const LAS float* s = scr + (8 * c) * 33 + n;
        u32x4 o; o.x = pk2(s[0 * 33], s[1 * 33]); o.y = pk2(s[2 * 33], s[3 * 33]); o.z = pk2(s[4 * 33], s[5 * 33]); o.w = pk2(s[6 * 33], s[7 * 33]);
        *(u32x4*)(WT + (size_t)(n0 + n) * K + k0 + 8 * c) = o; }
    LDS_WAIT(); asm volatile("" ::: "memory");
}
__device__ __forceinline__ void p0_mod_unit(Frame& F, int u) {
    const int ct = u % 48, kc = u / 48;
    LAS float* cs = (LAS float*)F.lds;
    for (int e = F.tid; e < 136 * 128; e += 512) { const int r = e >> 7, k = e & 127;
        float v = 0.f; if (r < 2) v = F.c_prompt[r * 1024 + kc * 128 + k]; else if (r < 130) v = F.c_sample[(r - 2) * 1024 + kc * 128 + k]; cs[e] = v; }
    __syncthreads();
    const int col = F.tid & 63, rg = F.wave;
    float acc[17];
#pragma unroll
    for (int i = 0; i < 17; ++i) acc[i] = 0.f;
    const float* wp = F.w_ada + (size_t)(kc * 128) * 3072 + ct * 64 + col;
    for (int k = 0; k < 128; k += 4) {
        const float w0 = wp[(size_t)(k + 0) * 3072], w1 = wp[(size_t)(k + 1) * 3072], w2 = wp[(size_t)(k + 2) * 3072], w3 = wp[(size_t)(k + 3) * 3072];
#pragma unroll
        for (int i = 0; i < 17; ++i) { const f32x4 c4 = *(const LAS f32x4*)&cs[(rg + 8 * i) * 128 + k]; acc[i] = fmaf(c4.x, w0, fmaf(c4.y, w1, fmaf(c4.z, w2, fmaf(c4.w, w3, acc[i])))); }
    }
    float* slab = (float*)(F.ws + WS_SLAB) + (size_t)kc * 130 * 3072;
#pragma unroll
    for (int i = 0; i < 17; ++i) { const int r = rg + 8 * i; if (r < 130) slab[(size_t)r * 3072 + ct * 64 + col] = acc[i]; }
    __syncthreads();
}
__device__ __forceinline__ void p0_prologue(Frame& F) {
    for (int u = F.vcu; u < 384; u += F.G) p0_mod_unit(F, u);
    LAS float* scr = (LAS float*)(F.lds + F.wave * 16384);
    const int gw = F.vcu * NWAVES + F.wave, NGW = F.G * NWAVES;
    constexpr int I_IN = 16 * (PLD / 32), I_OUT = 16 * 32;
    for (int it = gw; it < I_IN + I_OUT; it += NGW) {
        if (it < I_IN) p0_transpose_item(F.w_in, 1024, PROJ_COLS, PLD / 32, (bf16_t*)(F.ws + WS_WIN), scr, it, F.lane);
        else p0_transpose_item(F.w_out, 1024, 1024, 32, (bf16_t*)(F.ws + WS_WOUT), scr, it - I_IN, F.lane);
    }
    float* ct = (float*)(F.ws + WS_ROPE); float* st = ct + 8193 * 32;
    for (int e = F.vcu * 512 + F.tid; e < 8193 * 32; e += F.G * 512) { float c, s; rope_cs(e >> 5, e & 31, c, s); ct[e] = c; st[e] = s; }
}
__device__ __forceinline__ void p1_h(Frame& F) {
    LAS float* ms = (LAS float*)F.lds;
    const float* slab = (const float*)(F.ws + WS_SLAB);
    for (int e = F.tid; e < 4096; e += 512) { const int b = e >> 11, c = e & 2047; float s = F.b_ada[c];
#pragma unroll
        for (int kc = 0; kc < 8; ++kc) s += slab[((size_t)kc * 130 + b) * 3072 + c];
        ms[e] = s; }
    float* mod = (float*)(F.ws + WS_MOD);
    for (int e = F.vcu * 512 + F.tid; e < 130 * 3072; e += F.G * 512) { const int c = e % 3072; float s = F.b_ada[c];
#pragma unroll
        for (int kc = 0; kc < 8; ++kc) s += slab[(size_t)kc * 130 * 3072 + e];
        mod[e] = s; }
    __syncthreads();
    bf16_t* h = (bf16_t*)(F.ws + WS_H);
    const int gw = F.vcu * NWAVES + F.wave, NGW = F.G * NWAVES;
    for (int row = gw; row < MPAD; row += NGW) {
        u32x2* o8 = (u32x2*)(h + (size_t)row * 1024) + F.lane;
        if (row >= MT) {
#pragma unroll
            for (int j = 0; j < 4; ++j) o8[64 * j] = (u32x2){0u, 0u};
            continue; }
        const float* xr = row < MP ? F.x_prompt + (size_t)row * 1024 : F.x_sample + (size_t)(row - MP) * 1024;
#pragma unroll
        for (int j = 0; j < 4; ++j) {
            const int c = 4 * F.lane + 256 * j;
            const f32x4 xv = *(const f32x4*)(xr + c);
            f32x4 sh, sc;
            if (row < MP) { const int b = row >> 13; sh = *(const LAS f32x4*)&ms[b * 2048 + c]; sc = *(const LAS f32x4*)&ms[b * 2048 + 1024 + c]; }
            else { const int r = 2 + row - MP; sh = *(const f32x4*)(F.b_ada + c); sc = *(const f32x4*)(F.b_ada + 1024 + c);
#pragma unroll
                for (int kc = 0; kc < 8; ++kc) { sh += *(const f32x4*)(slab + ((size_t)kc * 130 + r) * 3072 + c); sc += *(const f32x4*)(slab + ((size_t)kc * 130 + r) * 3072 + 1024 + c); } }
            const f32x4 hv = xv * (sc + 1.0f) + sh;
            o8[64 * j] = (u32x2){pk2(hv.x, hv.y), pk2(hv.z, hv.w)};
        }
    }
}
__global__ void __launch_bounds__(128) k_convA(const bf16_t* __restrict__ proj, const float* __restrict__ state_conv, const float* __restrict__ conv_w,
                                               const float* __restrict__ a_log, const float* __restrict__ dt_bias,
                                               float* __restrict__ qa, float* __restrict__ ka, float* __restrict__ va, float* __restrict__ beta, float* __restrict__ g) {
    const int r = blockIdx.x, hd = blockIdx.y, c = threadIdx.x;
    __shared__ float red[2][128];
    float vals[3];
#pragma unroll
    for (int part = 0; part < 3; ++part) {
        const int col = part * A_WIDTH + hd * 128 + c;
        float acc = 0.f;
#pragma unroll
        for (int j = 0; j < 4; ++j) {
            float u;
            if (r < MP) { const int t = r % SEQ, tt = t - 3 + j; u = tt >= 0 ? bf2f(proj[(size_t)(r - 3 + j) * PLD + col]) : 0.f; }
            else { const int b = r - MP; u = j < 3 ? state_conv[((size_t)b * 3 + j) * A_QKV + col] : bf2f(proj[(size_t)r * PLD + col]); }
            acc = fmaf(u, conv_w[j * A_QKV + col], acc);
        }
        vals[part] = siluf(acc);
    }
    red[0][c] = vals[0] * vals[0]; red[1][c] = vals[1] * vals[1];
    __syncthreads();
    for (int s = 64; s > 0; s >>= 1) { if (c < s) { red[0][c] += red[0][c + s]; red[1][c] += red[1][c + s]; } __syncthreads(); }
    const float rq = rsqrtf(red[0][0] + L2_EPS) * 0.08838834764831845f, rk = rsqrtf(red[1][0] + L2_EPS);
    const size_t o = (size_t)r * A_WIDTH + hd * 128 + c;
    qa[o] = vals[0] * rq; ka[o] = vals[1] * rk; va[o] = vals[2];
    if (c == 0) {
        beta[(size_t)r * 4 + hd] = sigmoidf_(bf2f(proj[(size_t)r * PLD + OFF_A_BETA + hd]));
        g[(size_t)r * 4 + hd] = -__expf(a_log[hd]) * softplusf_(bf2f(proj[(size_t)r * PLD + OFF_A_DECAY + hd]) + dt_bias[hd]);
    }
}

__global__ void k_conv_state(const bf16_t* __restrict__ proj, const float* __restrict__ state_conv, float* __restrict__ out) {
    const int i = blockIdx.x * blockDim.x + threadIdx.x;
    if (i < BATCH * 3 * A_QKV) { const int b = i / (3 * A_QKV), j = (i / A_QKV) % 3, c = i % A_QKV; out[O_CONVP + i] = bf2f(proj[(size_t)(b * SEQ + SEQ - 3 + j) * PLD + c]); }
    if (i < DEC_BATCH * 3 * A_QKV) { const int b = i / (3 * A_QKV), j = (i / A_QKV) % 3, c = i % A_QKV;
        out[O_CONVS + i] = j < 2 ? state_conv[((size_t)b * 3 + j + 1) * A_QKV + c] : bf2f(proj[(size_t)(MP + b) * PLD + c]); }
}

__global__ void __launch_bounds__(128) k_delta_rec(const float* __restrict__ qa, const float* __restrict__ ka, const float* __restrict__ va, const float* __restrict__ beta, const float* __restrict__ g,
                                                   const float* __restrict__ s0, float* __restrict__ s_out, float* __restrict__ oa, int row0, int T) {
    const int seq = blockIdx.x >> 2, hd = blockIdx.x & 3, e = threadIdx.x;
    __shared__ float kq[2][128];
    float S[128];
    const size_t sbase = ((size_t)(seq * 4 + hd) * 128) * 128 + e;
#pragma unroll
    for (int d = 0; d < 128; ++d) S[d] = s0 ? s0[sbase + (size_t)d * 128] : 0.f;
    for (int t = 0; t < T; ++t) {
        const size_t r = (size_t)row0 + (size_t)seq * T + t;
        __syncthreads();
        kq[0][e] = ka[r * A_WIDTH + hd * 128 + e]; kq[1][e] = qa[r * A_WIDTH + hd * 128 + e];
        __syncthreads();
        const float dec = __expf(g[r * 4 + hd]), bt = beta[r * 4 + hd], v = va[r * A_WIDTH + hd * 128 + e];
        float pred = 0.f;
#pragma unroll
        for (int d = 0; d < 128; ++d) { S[d] *= dec; pred = fmaf(kq[0][d], S[d], pred); }
        const float u = bt * (v - pred);
        float o = 0.f;
#pragma unroll
        for (int d = 0; d < 128; ++d) { S[d] = fmaf(kq[0][d], u, S[d]); o = fmaf(kq[1][d], S[d], o); }
        oa[r * A_WIDTH + hd * 128 + e] = o;
    }
#pragma unroll
    for (int d = 0; d < 128; ++d) s_out[sbase + (size_t)d * 128] = S[d];
}

__global__ void __launch_bounds__(128) k_rms_gate(const float* __restrict__ oa, const bf16_t* __restrict__ proj, const float* __restrict__ norm_a, bf16_t* __restrict__ mix) {
    const int r = blockIdx.x, hd = blockIdx.y, e = threadIdx.x;
    __shared__ float red[128];
    const float o = oa[(size_t)r * A_WIDTH + hd * 128 + e];
    red[e] = o * o; __syncthreads();
    for (int s = 64; s > 0; s >>= 1) { if (e < s) red[e] += red[e + s]; __syncthreads(); }
    const float rs = rsqrtf(red[0] * (1.f / 128.f) + RMS_EPS);
    const float z = bf2f(proj[(size_t)r * PLD + OFF_A_Z + hd * 128 + e]);
    mix[(size_t)r * 1024 + hd * 128 + e] = f2bf(o * rs * norm_a[e] * siluf(z));
}

__global__ void k_rope(const bf16_t* __restrict__ proj, float* __restrict__ qb, float* __restrict__ kb, float* __restrict__ vb) {
    const int r = blockIdx.x;
    const int pos = r < MP ? r % SEQ : PAST_LEN;
    for (int idx = threadIdx.x; idx < 10 * 32; idx += blockDim.x) {
        const int hh = idx >> 5, i = idx & 31;
        float c, s; rope_cs(pos, i, c, s);
        if (hh < 8) {
            const float x1 = bf2f(proj[(size_t)r * PLD + OFF_B_Q + hh * 64 + i]), x2 = bf2f(proj[(size_t)r * PLD + OFF_B_Q + hh * 64 + 32 + i]);
            qb[(size_t)r * 512 + hh * 64 + i] = (x1 * c - x2 * s) * 0.125f; qb[(size_t)r * 512 + hh * 64 + 32 + i] = (x2 * c + x1 * s) * 0.125f;
        } else {
            const int kh = hh - 8;
            const float x1 = bf2f(proj[(size_t)r * PLD + OFF_B_K + kh * 64 + i]), x2 = bf2f(proj[(size_t)r * PLD + OFF_B_K + kh * 64 + 32 + i]);
            kb[(size_t)r * 128 + kh * 64 + i] = x1 * c - x2 * s; kb[(size_t)r * 128 + kh * 64 + 32 + i] = x2 * c + x1 * s;
        }
    }
    for (int idx = threadIdx.x; idx < 128; idx += blockDim.x) vb[(size_t)r * 128 + idx] = bf2f(proj[(size_t)r * PLD + OFF_B_V + idx]);
}
__global__ void k_cache_out(const float* __restrict__ kb, const float* __restrict__ vb, const float* __restrict__ ck, const float* __restrict__ cv, float* __restrict__ out) {
    const int i = blockIdx.x * blockDim.x + threadIdx.x;
    if (i < BATCH * WINDOW * 128) { const int b = i / (WINDOW * 128), w = (i / 128) % WINDOW, c = i % 128; const size_t r = (size_t)b * SEQ + SEQ - WINDOW + w;
        out[O_KP + i] = kb[r * 128 + c]; out[O_VP + i] = vb[r * 128 + c]; }
    if (i < DEC_BATCH * WINDOW * 128) { const int b = i / (WINDOW * 128), w = (i / 128) % WINDOW, c = i % 128;
        out[O_KS + i] = w < WINDOW - 1 ? ck[((size_t)b * WINDOW + w + 1) * 128 + c] : kb[(size_t)(MP + b) * 128 + c];
        out[O_VS + i] = w < WINDOW - 1 ? cv[((size_t)b * WINDOW + w + 1) * 128 + c] : vb[(size_t)(MP + b) * 128 + c]; }
}

__global__ void __launch_bounds__(64) k_swa(const float* __restrict__ qb, const float* __restrict__ kb, const float* __restrict__ vb, const float* __restrict__ ck, const float* __restrict__ cv,
                                           const float* __restrict__ sinks, const bf16_t* __restrict__ proj, bf16_t* __restrict__ mix) {
    const int r = blockIdx.x, hh = blockIdx.y, kvh = hh >> 2, lane = threadIdx.x;
    __shared__ float qs[64];
    __shared__ float ps[192];
    qs[lane] = qb[(size_t)r * 512 + hh * 64 + lane];
    __syncthreads();
    int nk;
    const bool prompt = r < MP;
    int t = 0, b = 0;
    if (prompt) { t = r % SEQ; b = r / SEQ; nk = t < WINDOW ? t + 1 : WINDOW + 1; } else { b = r - MP; nk = WINDOW + 1; }
    float sc[3]; float mx = -INFINITY;
#pragma unroll
    for (int i = 0; i < 3; ++i) {
        const int j = lane + 64 * i; sc[i] = -INFINITY;
        if (j < nk) {
            const float* kp;
            if (prompt) kp = kb + ((size_t)b * SEQ + (t - nk + 1 + j)) * 128 + kvh * 64;
            else kp = j < WINDOW ? ck + ((size_t)b * WINDOW + j) * 128 + kvh * 64 : kb + (size_t)r * 128 + kvh * 64;
            float a = 0.f;
            for (int d = 0; d < 64; ++d) a = fmaf(qs[d], kp[d], a);
            sc[i] = a; mx = fmaxf(mx, a);
        }
    }
    for (int o = 32; o > 0; o >>= 1) mx = fmaxf(mx, __shfl_xor(mx, o));
    const float sink = sinks[hh];
    mx = fmaxf(mx, sink);
    float sum = 0.f;
#pragma unroll
    for (int i = 0; i < 3; ++i) { const int j = lane + 64 * i; if (j < nk) { const float p = __expf(sc[i] - mx); ps[j] = p; sum += p; } }
    for (int o = 32; o > 0; o >>= 1) sum += __shfl_xor(sum, o);
    sum += __expf(sink - mx);
    __syncthreads();
    float acc = 0.f;
    for (int j = 0; j < nk; ++j) {
        const float* vp;
        if (prompt) vp = vb + ((size_t)b * SEQ + (t - nk + 1 + j)) * 128 + kvh * 64;
        else vp = j < WINDOW ? cv + ((size_t)b * WINDOW + j) * 128 + kvh * 64 : vb + (size_t)r * 128 + kvh * 64;
        acc = fmaf(ps[j], vp[lane], acc);
    }
    const float z = bf2f(proj[(size_t)r * PLD + OFF_B_Z + hh * 64 + lane]);
    mix[(size_t)r * 1024 + 512 + hh * 64 + lane] = f2bf(acc / sum * siluf(z));
}

__global__ void __launch_bounds__(256) k_ln(const float* __restrict__ xp, const float* __restrict__ xs, const float* __restrict__ mod, const float* __restrict__ pre,
                                            const float* __restrict__ ln_g, const float* __restrict__ ln_b, float* __restrict__ out) {
    const int r = blockIdx.x, tid = threadIdx.x;
    const int mr = r < MP ? r / SEQ : 2 + (r - MP);
    const float* x = r < MP ? xp + (size_t)r * D_MODEL : xs + (size_t)(r - MP) * D_MODEL;
    float* y = r < MP ? out + O_YP + (size_t)r * D_MODEL : out + O_YS + (size_t)(r - MP) * D_MODEL;
    __shared__ float red[256];
    float v[4]; float s = 0.f;
#pragma unroll
    for (int i = 0; i < 4; ++i) { const int c = tid + 256 * i; v[i] = DEEPNORM_ALPHA * x[c] + (1.f + mod[(size_t)mr * 3072 + 2048 + c]) * pre[(size_t)r * D_MODEL + c]; s += v[i]; }
    red[tid] = s; __syncthreads();
    for (int o = 128; o > 0; o >>= 1) { if (tid < o) red[tid] += red[tid + o]; __syncthreads(); }
    const float mean = red[0] * (1.f / 1024.f); __syncthreads();
    float q = 0.f;
#pragma unroll
    for (int i = 0; i < 4; ++i) { v[i] -= mean; q += v[i] * v[i]; }
    red[tid] = q; __syncthreads();
    for (int o = 128; o > 0; o >>= 1) { if (tid < o) red[tid] += red[tid + o]; __syncthreads(); }
    const float rstd = rsqrtf(red[0] * (1.f / 1024.f) + LN_EPS);
#pragma unroll
    for (int i = 0; i < 4; ++i) { const int c = tid + 256 * i; y[c] = v[i] * rstd * ln_g[c] + ln_b[c]; }
}

__global__ void __launch_bounds__(NWAVES * 64, 2) mega(Args args) {
    extern __shared__ __attribute__((aligned(16))) unsigned char lds_raw[];
    Frame F;
    F.lds = (LAS unsigned char*)lds_raw;
    F.MISC = (volatile LAS unsigned*)(F.lds + MISC_OFF);
    F.tid = threadIdx.x; F.lane = F.tid & 63; F.wave = __builtin_amdgcn_readfirstlane(F.tid >> 6);
    F.G = gridDim.x; { const int bx = blockIdx.x; F.vcu = (F.G % 8 == 0) ? (bx % 8) * (F.G / 8) + bx / 8 : bx; }
    F.ws = args.ws; F.out = args.out; F.ctl = (unsigned*)(args.ws + WS_CTL);
    F.x_prompt = args.in[0]; F.x_sample = args.in[1]; F.state_conv = args.in[2]; F.state_delta = args.in[3]; F.cache_k = args.in[4]; F.cache_v = args.in[5];
    F.c_prompt = args.in[6]; F.c_sample = args.in[7]; F.w_ada = args.in[8]; F.b_ada = args.in[9]; F.w_in = args.in[10]; F.conv_w = args.in[11];
    F.a_log = args.in[12]; F.dt_bias = args.in[13]; F.norm_a = args.in[14]; F.sinks = args.in[15]; F.w_out = args.in[16]; F.ln_g = args.in[17]; F.ln_b = args.in[18];
    for (int u = F.tid; u < (LDS_BYTES - LDSCTL_OFF) / 4; u += NWAVES * 64) ((LAS unsigned*)(F.lds + LDSCTL_OFF))[u] = 0u;
    __syncthreads();
    const int lo = args.ph_lo, hi = args.ph_hi;
    XcdBarrier bar; bar.bar = F.ctl + CW_BAR; bar.x = 0; bar.st = nullptr;
    if (hi - lo > 1) bar = xcd_barrier_post(F.ctl + CW_BAR, F.MISC + 8);
#define IN(k) (lo <= (k) && (k) < hi)
#define SEAM(k) do { if (IN(k) && IN((k) + 1)) xcd_barrier(bar); } while (0)
    if (IN(0)) { p0_prologue(F); } SEAM(0);
    if (IN(1)) { p1_h(F); } SEAM(1);
    if (IN(2)) {
        pg8::Gemm g{(const pg8::bf16_t*)(F.ws + WS_H), (const pg8::bf16_t*)(F.ws + WS_WIN), MPAD, PLD, 1024}; pg8::StaticOrder S; S.init(MPAD, PLD, F.G, (int)blockIdx.x);
        pg8::EpiBf16<0> E{(pg8::bf16_t*)(F.ws + WS_PROJ), PLD, nullptr, 0, 0, 1.f};
        pg8::gemm_phase<pg8::EpiBf16<0>, pg8::StaticOrder, true, true>(F.lds, g, S, E);
    } SEAM(2);
    if (IN(6)) {
        pg8::Gemm g{(const pg8::bf16_t*)(F.ws + WS_H), (const pg8::bf16_t*)(F.ws + WS_WOUT), MPAD, 1024, 1024}; pg8::StaticOrder S; S.init(MPAD, 1024, F.G, (int)blockIdx.x);
        pg8::EpiF32 E{(float*)(F.ws + WS_X), 1024, nullptr};
        pg8::gemm_phase<pg8::EpiF32, pg8::StaticOrder, true, true>(F.lds, g, S, E);
    }
#undef IN
#undef SEAM
}
extern "C" void kernel_launch(void* const* d_in, const int* in_sizes, int n_in, void* d_out, int out_size, void* d_ws, size_t ws_size, hipStream_t stream) {
    static int grid = 0;
    if (grid == 0) {
        int dev = 0, cus = 0;
        if (n_in != 19 || ws_size < WS_END || hipGetDevice(&dev) != hipSuccess || hipDeviceGetAttribute(&cus, hipDeviceAttributeMultiprocessorCount, dev) != hipSuccess) { fprintf(stderr, "kernel_launch: bad environment (n_in %d ws %zu)\n", n_in, ws_size); grid = -1; return; }
        if (hipFuncSetAttribute((const void*)mega, hipFuncAttributeMaxDynamicSharedMemorySize, LDS_BYTES) != hipSuccess) { fprintf(stderr, "kernel_launch: hipFuncSetAttribute failed\n"); grid = -1; return; }
        grid = cus;
    }
    if (grid < 0) return;
    const float* x_prompt = (const float*)d_in[0]; const float* x_sample = (const float*)d_in[1];
    const float* state_conv = (const float*)d_in[2]; const float* state_delta = (const float*)d_in[3];
    const float* cache_k = (const float*)d_in[4]; const float* cache_v = (const float*)d_in[5];
    const float* conv_w = (const float*)d_in[11]; const float* a_log = (const float*)d_in[12]; const float* dt_bias = (const float*)d_in[13];
    const float* norm_a = (const float*)d_in[14]; const float* sinks = (const float*)d_in[15];
    const float* ln_g = (const float*)d_in[17]; const float* ln_b = (const float*)d_in[18];
    float* out = (float*)d_out; unsigned char* ws = (unsigned char*)d_ws;
    (void)hipMemsetAsync(ws + WS_CTL, 0, CTL_ZERO_BYTES, stream);
    Args a{};
    for (int i = 0; i < 19; ++i) a.in[i] = (const float*)d_in[i];
    a.out = out; a.ws = ws;
    auto run = [&](int lo, int hi) { a.ph_lo = lo; a.ph_hi = hi; hipLaunchKernelGGL(mega, dim3(grid), dim3(NWAVES * 64), LDS_BYTES, stream, a); };
    run(0, 1); run(1, 2); run(2, 3);
    const bf16_t* proj = (const bf16_t*)(ws + WS_PROJ);
    bf16_t* mix = (bf16_t*)(ws + WS_H);
    const float* mod = (const float*)(ws + WS_MOD);
    float* beta = (float*)(ws + 27 * MiB); float* g = beta + (size_t)MT * 4;
    float *qa = out, *oa = out, *ka = out + (size_t)MT * 512, *qb = ka;
    float *va = (float*)(ws + WS_X), *kb = va, *vb = va + (size_t)MT * 128;
    float* pre = (float*)(ws + WS_X);
    k_convA<<<dim3(MT, 4), 128, 0, stream>>>(proj, state_conv, conv_w, a_log, dt_bias, qa, ka, va, beta, g);
    k_conv_state<<<(DEC_BATCH * 3 * A_QKV + 255) / 256, 256, 0, stream>>>(proj, state_conv, out);
    k_delta_rec<<<BATCH * 4, 128, 0, stream>>>(qa, ka, va, beta, g, nullptr, out + O_DELTAP, oa, 0, SEQ);
    k_delta_rec<<<DEC_BATCH * 4, 128, 0, stream>>>(qa, ka, va, beta, g, state_delta, out + O_DELTAS, oa, MP, 1);
    k_rms_gate<<<dim3(MT, 4), 128, 0, stream>>>(oa, proj, norm_a, mix);
    k_rope<<<MT, 128, 0, stream>>>(proj, qb, kb, vb);
    k_cache_out<<<(DEC_BATCH * WINDOW * 128 + 255) / 256, 256, 0, stream>>>(kb, vb, cache_k, cache_v, out);
    k_swa<<<dim3(MT, 8), 64, 0, stream>>>(qb, kb, vb, cache_k, cache_v, sinks, proj, mix);
    run(6, 7);
    k_ln<<<MT, 256, 0, stream>>>(x_prompt, x_sample, mod, pre, ln_g, ln_b, out);
}
```

```cpp
#include <hip/hip_runtime.h>
#include <cstdio>
#include <cstdint>
#include <cstddef>

constexpr int D_MODEL = 1024, BATCH = 2, SEQ = 8192, DEC_BATCH = 128, PAST_LEN = 8192;
constexpr int A_HEADS = 4, A_DK = 128, A_DV = 128, A_WIDTH = 512, A_QKV = 1536, CONV_W = 4;
constexpr int B_HEADS = 8, B_KV_HEADS = 2, B_HD = 64, B_GROUP = 4, B_WIDTH = 512, B_KV_WIDTH = 128, WINDOW = 128;
constexpr int OFF_A_QKV = 0, OFF_A_Z = 1536, OFF_A_BETA = 2048, OFF_A_DECAY = 2052, OFF_B_Q = 2056, OFF_B_K = 2568, OFF_B_V = 2696, OFF_B_Z = 2824, PROJ_COLS = 3336;
constexpr int MP = BATCH * SEQ;
constexpr int MT = MP + DEC_BATCH;
constexpr int MPAD = 16640;
constexpr int PLD = 3584;
constexpr float LN_EPS = 1e-5f, RMS_EPS = 1e-6f, L2_EPS = 1e-6f;
constexpr float DEEPNORM_ALPHA = 1.189207115002721f;

constexpr size_t O_YP = 0;
constexpr size_t O_YS = O_YP + (size_t)MP * D_MODEL;
constexpr size_t O_CONVP = O_YS + (size_t)DEC_BATCH * D_MODEL;
constexpr size_t O_DELTAP = O_CONVP + (size_t)BATCH * 3 * A_QKV;
constexpr size_t O_KP = O_DELTAP + (size_t)BATCH * A_HEADS * A_DK * A_DV;
constexpr size_t O_VP = O_KP + (size_t)BATCH * WINDOW * B_KV_WIDTH;
constexpr size_t O_CONVS = O_VP + (size_t)BATCH * WINDOW * B_KV_WIDTH;
constexpr size_t O_DELTAS = O_CONVS + (size_t)DEC_BATCH * 3 * A_QKV;
constexpr size_t O_KS = O_DELTAS + (size_t)DEC_BATCH * A_HEADS * A_DK * A_DV;
constexpr size_t O_VS = O_KS + (size_t)DEC_BATCH * WINDOW * B_KV_WIDTH;
constexpr size_t O_END = O_VS + (size_t)DEC_BATCH * WINDOW * B_KV_WIDTH;

constexpr size_t MiB = 1u << 20;
constexpr size_t WS_CTL = 0, CTL_ZERO_BYTES = 1 * MiB;
constexpr size_t WS_WIN = 2 * MiB;
constexpr size_t WS_WOUT = 10 * MiB;
constexpr size_t WS_MOD = 12 * MiB;
constexpr size_t WS_SLAB = 14 * MiB;
constexpr size_t WS_ROPE = 28 * MiB;
constexpr size_t WS_H = 32 * MiB;
constexpr size_t WS_PROJ = 66 * MiB;
constexpr size_t WS_X = 180 * MiB;
constexpr size_t WS_END = 256 * MiB;
constexpr int CW_BAR = 4096;

typedef unsigned short bf16_t;
typedef float f32x4 __attribute__((ext_vector_type(4)));
typedef unsigned u32x4 __attribute__((ext_vector_type(4)));
typedef unsigned u32x2 __attribute__((ext_vector_type(2)));
typedef short bf16x8 __attribute__((ext_vector_type(8)));
__device__ __forceinline__ float bf2f(bf16_t v) { return __uint_as_float(((unsigned)v) << 16); }
__device__ __forceinline__ bf16_t f2bf(float f) { unsigned u = __float_as_uint(f); return (bf16_t)((u + 0x7fffu + ((u >> 16) & 1u)) >> 16); }
__device__ __forceinline__ unsigned pk2(float lo, float hi) { return (unsigned)f2bf(lo) | ((unsigned)f2bf(hi) << 16); }
__device__ __forceinline__ void stc(float* p, float v) { *p = v; }
__device__ __forceinline__ void stc(bf16_t* p, float v) { *p = f2bf(v); }
__device__ __forceinline__ float siluf(float x) { return x / (1.f + __expf(-x)); }
__device__ __forceinline__ float sigmoidf_(float x) { return 1.f / (1.f + __expf(-x)); }
__device__ __forceinline__ float softplusf_(float x) { return x > 20.f ? x : log1pf(__expf(x)); }
__device__ __forceinline__ void rope_cs(int pos, int i, float& c, float& s) {
    const float inv = 1.0f / powf(10000.0f, (float)i / 32.0f);
    const float ang = (float)pos * inv;
    const double a = (double)ang;
    const double k = rint(a * 0.15915494309189535);
    const double rr = a - k * 6.283185307179586;
    c = (float)cos(rr); s = (float)sin(rr);
}
namespace pg8 {
#define PG8_LAS __attribute__((address_space(3)))
typedef unsigned short bf16_t;
typedef short bf16x8 __attribute__((ext_vector_type(8)));
typedef float f32x4 __attribute__((ext_vector_type(4)));
typedef unsigned u32x4 __attribute__((ext_vector_type(4)));
constexpr int BM = 256, BK = 64, HALF = 128, HTB = HALF * BK * 2  , STAGE_BYTES = 8 * HTB, NXCD = 8, WGM = 8;

__host__ __device__ __forceinline__ int lds_byte(int r, int c) { const int st = (r >> 4) * 2 + (c >> 5), rr = r & 15, cc = c & 31, ob = rr * 64 + cc * 2; return st * 1024 + (ob ^ (((ob >> 9) & 1) << 5)); }
__host__ __device__ __forceinline__ void stage_rc(int b, int& R, int& C) { const int st = b / 1024, sb = b % 1024, swz = sb ^ (((sb >> 9) & 1) << 5); R = (st >> 1) * 16 + swz / 64; C = (st & 1) * 32 + (swz % 64) / 2; }
__host__ __device__ __forceinline__ int perm32(int rho) { const int n = rho >> 4, i = rho & 15; return 8 * (i >> 2) + 4 * n + (i & 3); }

struct Unit { int pm, pn; };
struct Gemm { const bf16_t* A; const bf16_t* Bt; int M, N, K; };

struct StaticOrder {
    int nM, nN, nwg, G, c;
    __host__ __device__ void init(int M, int N, int G_, int c_) { nM = M / BM; nN = N / BM; nwg = nM * nN; G = G_; c = c_; }
    __host__ __device__ bool next(int i, Unit& u) const {
        const long L = (long)i * G + c; if (L >= nwg) return false;
        int wgid = (int)L; { const int q = nwg / NXCD, r = nwg % NXCD, xcd = wgid % NXCD, off = wgid / NXCD; wgid = (xcd < r ? xcd * (q + 1) : r * (q + 1) + (xcd - r) * q) + off; }
        const int nig = WGM * nN, gid = wgid / nig, fm = gid * WGM, gsz = (nM - fm) < WGM ? (nM - fm) : WGM;
        u.pm = fm + ((wgid % nig) % gsz); u.pn = (wgid % nig) / gsz; return true;
    }
    __device__ __forceinline__ void a_ready(const Unit&) const {}
    __device__ __forceinline__ void done(const Unit&) const {}
};

__device__ __forceinline__ unsigned cvt_pk_bf16(float lo, float hi) { unsigned r; asm volatile("v_cvt_pk_bf16_f32 %0, %1, %2" : "=v"(r) : "v"(lo), "v"(hi)); return r; }
typedef float f32x2 __attribute__((ext_vector_type(2)));
__device__ __forceinline__ f32x2 gelu_pk(f32x2 v) {
    const f32x2 av = __builtin_elementwise_abs(v), d = av * 0.2316418882f + 1.0f;
    f32x2 t; t.x = __builtin_amdgcn_rcpf(d.x); t.y = __builtin_amdgcn_rcpf(d.y);
    f32x2 q = t * 0.5307027145f + (-0.7265760135f); q = q * t + 0.7107068705f; q = q * t + (-0.142248368f); q = q * t + 0.127414796f; q = q * t;
    const f32x2 s = (v * v) * (-0.72134752044f);
    f32x2 e; e.x = __builtin_amdgcn_exp2f(s.x); e.y = __builtin_amdgcn_exp2f(s.y);
    const f32x2 m = v * (q * e), r = v - m;
    f32x2 o; o.x = v.x < 0.f ? m.x : r.x; o.y = v.y < 0.f ? m.y : r.y; return o;
}

struct EpiF32 {
    static constexpr bool PERM = false, AFTER_DRAIN = false;
    float* C; int ldc; const float* bias;
    __device__ __forceinline__ void operator()(const f32x4 (&acc)[2][2][4][2], const Unit& u, int wr, int wc, int fr, int fq) const {
        const int row0 = u.pm * BM + wr * 64 + fr, col0 = u.pn * BM + wc * 32 + 4 * fq;
        f32x4 bv[2][2];
#pragma unroll
        for (int bj = 0; bj < 2; ++bj)
#pragma unroll
            for (int n = 0; n < 2; ++n) bv[bj][n] = bias ? *(const f32x4*)(bias + col0 + bj * HALF + n * 16) : (f32x4){0.f, 0.f, 0.f, 0.f};
#pragma unroll
        for (int ai = 0; ai < 2; ++ai)
#pragma unroll
            for (int m = 0; m < 4; ++m) { float* rowp = C + (size_t)(row0 + ai * HALF + m * 16) * ldc + col0;
#pragma unroll
                for (int bj = 0; bj < 2; ++bj)
#pragma unroll
                    for (int n = 0; n < 2; ++n) *(f32x4*)(rowp + bj * HALF + n * 16) = acc[ai][bj][m][n] + bv[bj][n]; }
    }
};
template <int ACT  > struct EpiBf16 {
    static constexpr bool PERM = true, AFTER_DRAIN = false; static_assert(ACT == 0 || ACT == 1, "EpiBf16: ACT is 0 (none) or 1 (gelu_pk)");
    bf16_t* O; int ldc; const float* bias; int split_cols; size_t split_stride; float scale0;
    __device__ __forceinline__ void operator()(const f32x4 (&acc)[2][2][4][2], const Unit& u, int wr, int wc, int fr, int fq) const {
        const int row0 = u.pm * BM + wr * 64 + fr; int colt = u.pn * BM; bf16_t* base = O;
        float sc = 1.f; if (split_cols) { const int t = colt / split_cols; base += (size_t)t * split_stride; colt -= t * split_cols; if (t == 0) sc = scale0; }
        const int col0 = colt + wc * 32 + 8 * fq, bcol0 = u.pn * BM + wc * 32 + 8 * fq;
        f32x4 bv[2][2];
#pragma unroll
        for (int bj = 0; bj < 2; ++bj)
#pragma unroll
            for (int n = 0; n < 2; ++n) bv[bj][n] = bias ? *(const f32x4*)(bias + bcol0 + bj * HALF + 4 * n) : (f32x4){0.f, 0.f, 0.f, 0.f};
#pragma unroll
        for (int ai = 0; ai < 2; ++ai)
#pragma unroll
            for (int m = 0; m < 4; ++m) { bf16_t* rowp = base + (size_t)(row0 + ai * HALF + m * 16) * ldc + col0;
#pragma unroll
                for (int bj = 0; bj < 2; ++bj) { f32x4 v0 = acc[ai][bj][m][0] + bv[bj][0], v1 = acc[ai][bj][m][1] + bv[bj][1];
                    if (ACT == 1) { f32x2 a = gelu_pk((f32x2){v0[0], v0[1]}), b = gelu_pk((f32x2){v0[2], v0[3]}), c = gelu_pk((f32x2){v1[0], v1[1]}), d = gelu_pk((f32x2){v1[2], v1[3]});
                        v0 = (f32x4){a.x, a.y, b.x, b.y}; v1 = (f32x4){c.x, c.y, d.x, d.y}; }
                    v0 = v0 * sc; v1 = v1 * sc; u32x4 w; w.x = cvt_pk_bf16(v0[0], v0[1]); w.y = cvt_pk_bf16(v0[2], v0[3]); w.z = cvt_pk_bf16(v1[0], v1[1]); w.w = cvt_pk_bf16(v1[2], v1[3]);
                    *(u32x4*)(rowp + bj * HALF) = w; } }
    }
};

struct PanelStats {
    unsigned* xbuf;
    unsigned* cnt;
    unsigned* tmo;
    int ntn; float eps;
    unsigned code;
    __device__ __forceinline__ bool run(const f32x4 (&v)[2][2][4][2], const Unit& u, int wr, int wc, int fr, int fq, PG8_LAS unsigned char* lds, int wid, int lane) const {
        typedef float f32x2v __attribute__((ext_vector_type(2)));
        PG8_LAS f32x2v* P = (PG8_LAS f32x2v*)lds;
        PG8_LAS f32x2v* S = (PG8_LAS f32x2v*)(lds + 8192);
        PG8_LAS unsigned* flag = (PG8_LAS unsigned*)(lds + 8192 + 2048);
#pragma unroll
        for (int ai = 0; ai < 2; ++ai)
#pragma unroll
            for (int m = 0; m < 4; ++m) {
                float s = 0.f;
#pragma unroll
                for (int bj = 0; bj < 2; ++bj)
#pragma unroll
                    for (int n = 0; n < 2; ++n) { const f32x4 x = v[ai][bj][m][n]; s += (x[0] + x[1]) + (x[2] + x[3]); }
                s += __shfl_xor(s, 16); s += __shfl_xor(s, 32);
                const float mw = s * (1.0f / 64.0f); float q = 0.f;
#pragma unroll
                for (int bj = 0; bj < 2; ++bj)
#pragma unroll
                    for (int n = 0; n < 2; ++n) { const f32x4 d = v[ai][bj][m][n] - mw; q += (d[0] * d[0] + d[1] * d[1]) + (d[2] * d[2] + d[3] * d[3]); }
                q += __shfl_xor(q, 16); q += __shfl_xor(q, 32);
                if (fq == 0) P[(ai * HALF + wr * 64 + m * 16 + fr) * 4 + wc] = (f32x2v){mw, q};
            }
        asm volatile("s_waitcnt lgkmcnt(0)" ::: "memory"); __builtin_amdgcn_s_barrier(); asm volatile("" ::: "memory");
#if defined(BROKEN_EXCHANGE_NO_WAIT)
#warning BROKEN CONTROL BUILD: the row-statistics exchange does not wait; results are wrong by design
        if (blockIdx.x >= 64) { const long long t0_ = clock64(); while (clock64() - t0_ < 60000) __builtin_amdgcn_s_sleep(8); }
#endif
        const int row = wid * 32 + (lane & 31);
        if (lane < 32) {
            const f32x2v a = P[row * 4 + 0], b = P[row * 4 + 1], c = P[row * 4 + 2], d = P[row * 4 + 3];
            const float mt = (a.x + b.x + c.x + d.x) * 0.25f;
            const float da = a.x - mt, db = b.x - mt, dc = c.x - mt, dd = d.x - mt;
            const float m2 = (a.y + b.y) + (c.y + d.y) + 64.0f * ((da * da + db * db) + (dc * dc + dd * dd));
            unsigned long long* slot = (unsigned long long*)xbuf + ((size_t)(u.pm * BM + row) * 4 + u.pn);
            __hip_atomic_store(slot, ((unsigned long long)__float_as_uint(m2) << 32) | __float_as_uint(mt), __ATOMIC_RELAXED, __HIP_MEMORY_SCOPE_AGENT);
        }
        asm volatile("s_waitcnt vmcnt(0)" ::: "memory");
        if (lane == 0) __hip_atomic_fetch_add(cnt + 64 * u.pm, 1u, __ATOMIC_RELAXED, __HIP_MEMORY_SCOPE_AGENT);
        if (wid == 0) {
            bool dead = false; const unsigned long long t0 = __builtin_amdgcn_s_memrealtime(); const unsigned want = 8u * (unsigned)ntn;
            for (;;) {
#if defined(BROKEN_EXCHANGE_NO_WAIT)
                break;
#endif
                if ((unsigned)__builtin_amdgcn_readfirstlane(__hip_atomic_load(cnt + 64 * u.pm, __ATOMIC_RELAXED, __HIP_MEMORY_SCOPE_AGENT)) >= want) break;
                if (__builtin_amdgcn_s_memrealtime() - t0 > 2000000ull) {
                    if (lane == 0) { unsigned expect = 0u; __hip_atomic_compare_exchange_strong(tmo + 1, &expect, code | (unsigned)(u.pm & 0xff), __ATOMIC_RELAXED, __ATOMIC_RELAXED, __HIP_MEMORY_SCOPE_AGENT);
                                     __hip_atomic_store(tmo, 1u, __ATOMIC_RELAXED, __HIP_MEMORY_SCOPE_AGENT); }
                    dead = true; break; }
                __builtin_amdgcn_s_sleep(2);
            }
            __builtin_amdgcn_fence(__ATOMIC_ACQUIRE, "agent");
            if (lane == 0) flag[0] = dead ? 1u : 0u;
        }
        asm volatile("s_waitcnt vmcnt(0) lgkmcnt(0)" ::: "memory"); __builtin_amdgcn_s_barrier(); asm volatile("" ::: "memory");
        const bool bad = flag[0] != 0u;
        if (lane < 32) {
            const unsigned long long* slot = (const unsigned long long*)xbuf + (size_t)(u.pm * BM + row) * 4; float mt[4], m2[4]; float ms = 0.f;
#pragma unroll
            for (int t = 0; t < 4; ++t) { if (t < ntn) { const unsigned long long w = __hip_atomic_load(slot + t, __ATOMIC_RELAXED, __HIP_MEMORY_SCOPE_AGENT); mt[t] = __uint_as_float((unsigned)w); m2[t] = __uint_as_float((unsigned)(w >> 32)); } else { mt[t] = 0.f; m2[t] = 0.f; } ms += mt[t]; }
            const float mean = ms / (float)ntn; float q = 0.f;
#pragma unroll
            for (int t = 0; t < 4; ++t) if (t < ntn) { const float dm = mt[t] - mean; q += m2[t] + 256.0f * dm * dm; }
            S[row] = (f32x2v){mean, 1.0f / sqrtf(q / (256.0f * (float)ntn) + eps)};
        }
        asm volatile("s_waitcnt lgkmcnt(0)" ::: "memory"); __builtin_amdgcn_s_barrier(); asm volatile("" ::: "memory");
        return bad;
    }
};
struct EpiLnRes {
    static constexpr bool PERM = false, AFTER_DRAIN = true;
    const float* base; float* out; int ldc; const float* bias; PanelStats st; unsigned poison;
    __device__ __forceinline__ void fused(f32x4 (&acc)[2][2][4][2], const Unit& u, int wr, int wc, int fr, int fq, PG8_LAS unsigned char* lds, int wid, int lane) const {
        typedef float f32x2v __attribute__((ext_vector_type(2)));
        const PG8_LAS f32x2v* S = (const PG8_LAS f32x2v*)(lds + 8192);
        const int col0 = u.pn * BM + wc * 32 + 4 * fq;
#pragma unroll
        for (int bj = 0; bj < 2; ++bj)
#pragma unroll
            for (int n = 0; n < 2; ++n) { const f32x4 bv = bias ? *(const f32x4*)(bias + col0 + bj * HALF + n * 16) : (f32x4){0.f, 0.f, 0.f, 0.f};
#pragma unroll
                for (int ai = 0; ai < 2; ++ai)
#pragma unroll
                    for (int m = 0; m < 4; ++m) acc[ai][bj][m][n] += bv; }
        f32x4 pre[4][2][2];
#pragma unroll
        for (int m = 0; m < 4; ++m) { const size_t off = (size_t)(u.pm * BM + wr * 64 + m * 16 + fr) * ldc + col0;
#pragma unroll
            for (int bj = 0; bj < 2; ++bj)
#pragma unroll
                for (int n = 0; n < 2; ++n) pre[m][bj][n] = *(const f32x4*)(base + off + bj * HALF + n * 16); }
        const bool bad = st.run(acc, u, wr, wc, fr, fq, lds, wid, lane) || poison != 0u;
        const float qnan = __builtin_nanf("");
#pragma unroll
        for (int ai = 0; ai < 2; ++ai)
#pragma unroll
            for (int m = 0; m < 4; ++m) { const int r = ai * HALF + wr * 64 + m * 16 + fr; const f32x2v sr = S[r]; const size_t off = (size_t)(u.pm * BM + r) * ldc + col0;
#pragma unroll
                for (int bj = 0; bj < 2; ++bj)
#pragma unroll
                    for (int n = 0; n < 2; ++n) { const f32x4 bs = ai == 0 ? pre[m][bj][n] : *(const f32x4*)(base + off + bj * HALF + n * 16); f32x4 o = bs + (acc[ai][bj][m][n] - sr.x) * sr.y;
                        if (bad) o = (f32x4){qnan, qnan, qnan, qnan}; *(f32x4*)(out + off + bj * HALF + n * 16) = o; }
                if (m & 1) asm volatile("" ::: "memory"); }
    }
};
struct EpiLnResLn {
    static constexpr bool PERM = false, AFTER_DRAIN = true;
    const float* base; float* out; bf16_t* xn; int ldc; const float* bias; PanelStats st1, st2; unsigned poison;
    __device__ __forceinline__ void fused(f32x4 (&acc)[2][2][4][2], const Unit& u, int wr, int wc, int fr, int fq, PG8_LAS unsigned char* lds, int wid, int lane) const {
        typedef float f32x2v __attribute__((ext_vector_type(2))); typedef unsigned u32x2v __attribute__((ext_vector_type(2)));
        const PG8_LAS f32x2v* S = (const PG8_LAS f32x2v*)(lds + 8192);
        const int col0 = u.pn * BM + wc * 32 + 4 * fq;
#pragma unroll
        for (int bj = 0; bj < 2; ++bj)
#pragma unroll
            for (int n = 0; n < 2; ++n) { const f32x4 bv = bias ? *(const f32x4*)(bias + col0 + bj * HALF + n * 16) : (f32x4){0.f, 0.f, 0.f, 0.f};
#pragma unroll
                for (int ai = 0; ai < 2; ++ai)
#pragma unroll
                    for (int m = 0; m < 4; ++m) acc[ai][bj][m][n] += bv; }
        bool bad = st1.run(acc, u, wr, wc, fr, fq, lds, wid, lane) || poison != 0u;
        const float qnan = __builtin_nanf("");
#pragma unroll
        for (int ai = 0; ai < 2; ++ai)
#pragma unroll
            for (int m = 0; m < 4; ++m) { const int r = ai * HALF + wr * 64 + m * 16 + fr; const f32x2v sr = S[r]; const size_t off = (size_t)(u.pm * BM + r) * ldc + col0;
#pragma unroll
                for (int bj = 0; bj < 2; ++bj)
#pragma unroll
                    for (int n = 0; n < 2; ++n) { const f32x4 bs = *(const f32x4*)(base + off + bj * HALF + n * 16); acc[ai][bj][m][n] = bs + (acc[ai][bj][m][n] - sr.x) * sr.y; }
                asm volatile("" : "+v"(acc[ai][0][m][0]), "+v"(acc[ai][0][m][1]), "+v"(acc[ai][1][m][0]), "+v"(acc[ai][1][m][1]));
                if (m & 1) asm volatile("" ::: "memory"); }
        const bool bad1 = bad;
        bad = st2.run(acc, u, wr, wc, fr, fq, lds, wid, lane) || bad;
#pragma unroll
        for (int ai = 0; ai < 2; ++ai)
#pragma unroll
            for (int m = 0; m < 4; ++m) { const int r = ai * HALF + wr * 64 + m * 16 + fr; const f32x2v sr = S[r]; const size_t off = (size_t)(u.pm * BM + r) * ldc + col0;
#pragma unroll
                for (int bj = 0; bj < 2; ++bj)
#pragma unroll
                    for (int n = 0; n < 2; ++n) { const f32x4 x1 = acc[ai][bj][m][n]; *(f32x4*)(out + off + bj * HALF + n * 16) = bad1 ? (f32x4){qnan, qnan, qnan, qnan} : x1;
                        const f32x4 o = (x1 - sr.x) * sr.y; u32x2v w; w.x = cvt_pk_bf16(o[0], o[1]); w.y = cvt_pk_bf16(o[2], o[3]);
                        if (bad) { w.x = 0x7fc07fc0u; w.y = 0x7fc07fc0u; } *(u32x2v*)(xn + off + bj * HALF + n * 16) = w; }
                asm volatile("" ::: "memory"); }
    }
};

template <class Epi, class Sched, bool ALIGN_EPI = false, bool SP2 = false>
__device__ __forceinline__ void gemm_phase(PG8_LAS unsigned char* lds, const Gemm g, const Sched& S, const Epi& E) {
    const int tid = threadIdx.x, wid = __builtin_amdgcn_readfirstlane(tid >> 6), lane = tid & 63, wr = wid >> 2, wc = wid & 3, fr = lane & 15, fq = lane >> 4;
    const int K = g.K, nt = K / BK;
    unsigned voffA[2], voffB[2];
#pragma unroll
    for (int i = 0; i < 2; ++i) { int R, C; stage_rc(tid * 16 + i * 8192, R, C); const int Rb = Epi::PERM ? ((R & ~31) + perm32(R & 31)) : R;
        voffA[i] = (unsigned)(R * K + C) * 2u; voffB[i] = (unsigned)(Rb * K + C) * 2u; }
    const size_t kstep = (size_t)(BK * 2);
    const size_t hstep = (size_t)HALF * K * 2;
    const size_t tstep = 2 * hstep;
    const unsigned ldsw = (unsigned)wid * 1024u;
    const int aoff = lds_byte(wr * 64 + fr, fq * 8), boff = lds_byte(wc * 32 + fr, fq * 8);
#define PG8_SA(b, h) (((b) * 2 + (h)) * HTB)
#define PG8_SB(b, h) ((4 + (b) * 2 + (h)) * HTB)
#define PG8_STAGE(bufoff, gbase, voff) do { _Pragma("unroll") for (int _i = 0; _i < 2; ++_i) \
        __builtin_amdgcn_global_load_lds((const unsigned*)((const char*)(gbase) + (voff)[_i]), (PG8_LAS unsigned*)(lds + (bufoff) + ldsw + _i * 8192), 16, 0, 0); } while (0)
#define PG8_LDA(dst, b, h) do { _Pragma("unroll") for (int m = 0; m < 4; ++m) _Pragma("unroll") for (int k = 0; k < 2; ++k) dst[m][k] = *(const PG8_LAS bf16x8*)(lds + PG8_SA(b, h) + aoff + m * 2048 + k * 1024); } while (0)
#define PG8_LDB(dst, b, h) do { _Pragma("unroll") for (int n = 0; n < 2; ++n) _Pragma("unroll") for (int k = 0; k < 2; ++k) dst[n][k] = *(const PG8_LAS bf16x8*)(lds + PG8_SB(b, h) + boff + n * 2048 + k * 1024); } while (0)
#define PG8_MMA(ai, bj, At, Bt) do { __builtin_amdgcn_s_setprio(1); _Pragma("unroll") for (int m = 0; m < 4; ++m) _Pragma("unroll") for (int n = 0; n < 2; ++n) _Pragma("unroll") for (int k = 0; k < 2; ++k) \
        acc[ai][bj][m][n] = __builtin_amdgcn_mfma_f32_16x16x32_bf16(Bt[n][k], At[m][k], acc[ai][bj][m][n], 0, 0, 0); __builtin_amdgcn_s_setprio(0); } while (0)
#define PG8_WAIT_V(n) asm volatile("s_waitcnt vmcnt(" #n ")" ::: "memory")
#define PG8_WAIT_L(n) asm volatile("s_waitcnt lgkmcnt(" #n ")" ::: "memory")
#define PG8_BAR __builtin_amdgcn_s_barrier()
#define PG8_SCHED __builtin_amdgcn_sched_barrier(0)
    Unit cur, nxt; int ui = 0;
    if (!S.next(0, cur)) return;
    f32x4 acc[2][2][4][2];
#pragma unroll
    for (int a = 0; a < 2; ++a)
#pragma unroll
        for (int b = 0; b < 2; ++b)
#pragma unroll
            for (int m = 0; m < 4; ++m)
#pragma unroll
                for (int n = 0; n < 2; ++n) acc[a][b][m][n] = (f32x4){0.f, 0.f, 0.f, 0.f};
    bf16x8 At[4][2], B0[2][2], B1[2][2];
    const char* cA = (const char*)g.A + (size_t)cur.pm * tstep; const char* cB = (const char*)g.Bt + (size_t)cur.pn * tstep;
    S.a_ready(cur);
    if constexpr (SP2) {
        PG8_STAGE(PG8_SB(0, 0), cB, voffB); PG8_STAGE(PG8_SB(0, 1), cB + hstep, voffB); PG8_STAGE(PG8_SA(0, 0), cA, voffA); PG8_STAGE(PG8_SA(0, 1), cA + hstep, voffA);
        if (wr == 1) PG8_BAR;
        PG8_WAIT_V(2); PG8_BAR;
        PG8_STAGE(PG8_SB(1, 0), cB + kstep, voffB); PG8_STAGE(PG8_SA(1, 0), cA + kstep, voffA); PG8_STAGE(PG8_SB(1, 1), cB + hstep + kstep, voffB);
        PG8_WAIT_V(6); PG8_BAR;
    } else {
        PG8_STAGE(PG8_SB(0, 0), cB, voffB); PG8_STAGE(PG8_SA(0, 0), cA, voffA); PG8_STAGE(PG8_SB(0, 1), cB + hstep, voffB); PG8_STAGE(PG8_SA(0, 1), cA + hstep, voffA);
        if (wr == 1) PG8_BAR;
        PG8_WAIT_V(4); PG8_BAR;
        PG8_STAGE(PG8_SB(1, 0), cB + kstep, voffB); PG8_STAGE(PG8_SA(1, 0), cA + kstep, voffA); PG8_STAGE(PG8_SB(1, 1), cB + hstep + kstep, voffB);
        PG8_WAIT_V(6); PG8_BAR;
    }
    for (;;) {
        const bool has_next = S.next(ui + 1, nxt);
        const char* nA = has_next ? (const char*)g.A + (size_t)nxt.pm * tstep : cA; const char* nB = has_next ? (const char*)g.Bt + (size_t)nxt.pn * tstep : cB;
        for (int t = 0; t < nt; t += 2) {
            const bool last = (t == nt - 2);
            const char* a1 = cA + (size_t)(t + 1) * kstep;
            const char* a2 = last ? nA : cA + (size_t)(t + 2) * kstep; const char* b2 = last ? nB : cB + (size_t)(t + 2) * kstep;
            const char* a3 = a2 + kstep; const char* b3 = b2 + kstep;
            if (last && has_next) S.a_ready(nxt);
            if constexpr (SP2) {
            PG8_LDB(B0, 0, 0); PG8_LDB(B1, 0, 1); PG8_SCHED; PG8_LDA(At, 0, 0); PG8_STAGE(PG8_SA(1, 1), a1 + hstep, voffA);
            PG8_WAIT_V(8); PG8_WAIT_L(0); PG8_BAR; PG8_MMA(0, 0, At, B0); PG8_MMA(0, 1, At, B1); PG8_BAR; PG8_SCHED;
            PG8_LDA(At, 0, 1); PG8_STAGE(PG8_SB(0, 0), b2, voffB); PG8_STAGE(PG8_SB(0, 1), b2 + hstep, voffB); PG8_STAGE(PG8_SA(0, 0), a2, voffA);
            PG8_WAIT_V(8); PG8_WAIT_L(0); PG8_BAR; PG8_MMA(1, 0, At, B0); PG8_MMA(1, 1, At, B1); PG8_BAR; PG8_SCHED;
            PG8_LDB(B0, 1, 0); PG8_LDB(B1, 1, 1); PG8_SCHED; PG8_LDA(At, 1, 0); PG8_STAGE(PG8_SA(0, 1), a2 + hstep, voffA);
            PG8_WAIT_V(8); PG8_WAIT_L(0); PG8_BAR; PG8_MMA(0, 0, At, B0); PG8_MMA(0, 1, At, B1); PG8_BAR; PG8_SCHED;
            PG8_LDA(At, 1, 1); PG8_STAGE(PG8_SB(1, 0), b3, voffB); PG8_STAGE(PG8_SB(1, 1), b3 + hstep, voffB); PG8_STAGE(PG8_SA(1, 0), a3, voffA);
            PG8_WAIT_V(8); PG8_WAIT_L(0); PG8_BAR; PG8_MMA(1, 0, At, B0); PG8_MMA(1, 1, At, B1); PG8_BAR; PG8_SCHED;
            } else {
            PG8_LDB(B0, 0, 0); PG8_SCHED; PG8_LDA(At, 0, 0); PG8_STAGE(PG8_SA(1, 1), a1 + hstep, voffA);
            PG8_WAIT_L(8); PG8_BAR; PG8_WAIT_L(0); PG8_MMA(0, 0, At, B0); PG8_BAR; PG8_SCHED;
            PG8_LDB(B1, 0, 1); PG8_STAGE(PG8_SB(0, 0), b2, voffB);
            PG8_BAR; PG8_WAIT_L(0); PG8_MMA(0, 1, At, B1); PG8_BAR;
            PG8_LDA(At, 0, 1); PG8_STAGE(PG8_SA(0, 0), a2, voffA);
            PG8_BAR; PG8_WAIT_L(0); PG8_MMA(1, 0, At, B0); PG8_BAR; PG8_SCHED;
            PG8_STAGE(PG8_SB(0, 1), b2 + hstep, voffB);
            PG8_WAIT_V(6); PG8_BAR; PG8_MMA(1, 1, At, B1); PG8_BAR;
            PG8_LDB(B0, 1, 0); PG8_SCHED; PG8_LDA(At, 1, 0); PG8_STAGE(PG8_SA(0, 1), a2 + hstep, voffA);
            PG8_WAIT_L(8); PG8_BAR; PG8_WAIT_L(0); PG8_MMA(0, 0, At, B0); PG8_BAR; PG8_SCHED;
            PG8_LDB(B1, 1, 1); PG8_STAGE(PG8_SB(1, 0), b3, voffB);
            PG8_BAR; PG8_WAIT_L(0); PG8_MMA(0, 1, At, B1); PG8_BAR;
            PG8_LDA(At, 1, 1); PG8_STAGE(PG8_SA(1, 0), a3, voffA);
            PG8_BAR; PG8_WAIT_L(0); PG8_MMA(1, 0, At, B0); PG8_BAR; PG8_SCHED;
            PG8_STAGE(PG8_SB(1, 1), b3 + hstep, voffB);
            PG8_WAIT_V(6); PG8_BAR; PG8_MMA(1, 1, At, B1); PG8_BAR;
            }
        }
        if constexpr (ALIGN_EPI) { if (wr == 0) PG8_BAR; }
        if constexpr (!Epi::AFTER_DRAIN) { E(acc, cur, wr, wc, fr, fq); S.done(cur); }
        if (!has_next) break;
#pragma unroll
        for (int a = 0; a < 2; ++a)
#pragma unroll
            for (int b = 0; b < 2; ++b)
#pragma unroll
                for (int m = 0; m < 4; ++m)
#pragma unroll
                    for (int n = 0; n < 2; ++n) acc[a][b][m][n] = (f32x4){0.f, 0.f, 0.f, 0.f};
        cur = nxt; cA = nA; cB = nB; ++ui;
        if constexpr (ALIGN_EPI) { if (wr == 1) PG8_BAR; }
    }
    PG8_WAIT_V(0);
    if constexpr (!ALIGN_EPI) { if (wr == 0) PG8_BAR; }
    PG8_BAR;
    if constexpr (Epi::AFTER_DRAIN) { E.fused(acc, cur, wr, wc, fr, fq, lds, wid, lane); S.done(cur); }
#undef PG8_SA
#undef PG8_SB
#undef PG8_STAGE
#undef PG8_LDA
#undef PG8_LDB
#undef PG8_MMA
#undef PG8_WAIT_V
#undef PG8_WAIT_L
#undef PG8_BAR
#undef PG8_SCHED
}
}
#define GAS __attribute__((address_space(1)))
#define LAS __attribute__((address_space(3)))
typedef GAS unsigned gu32;
#define LDS_WAIT() asm volatile("s_waitcnt lgkmcnt(0)" ::: "memory")
#define VM_WAIT() asm volatile("s_waitcnt vmcnt(0)" ::: "memory")
#define XB_TMO      128
#define XB_XCNT(j)  (256  + 64 * (j))
#define XB_XSUB(j)  (1280 + 64 * (j))
#define XB_XGEN(j)  (2304 + 64 * (j))
#define XB_TOP      3328
#define XB_TOPGEN   3392
#define XCD_BAR_WORDS 3456
#define XB_SPIN_CAP (1u << 18)

__device__ __forceinline__ unsigned xb_ld(unsigned* p)              { return __hip_atomic_load(p, __ATOMIC_RELAXED, __HIP_MEMORY_SCOPE_AGENT); }
__device__ __forceinline__ unsigned xb_add(unsigned* p, unsigned v) { return __hip_atomic_fetch_add(p, v, __ATOMIC_RELAXED, __HIP_MEMORY_SCOPE_AGENT); }
__device__ __forceinline__ unsigned xb_xcc_id() { return (unsigned)__builtin_amdgcn_s_getreg((3 << 11) | 20) & 0xFu; }
#define XB_SPIN(cond, bar) do { unsigned _sp = 0; while (cond) { __builtin_amdgcn_s_sleep(1); \
    if ((++_sp & 255u) == 0u) { if (xb_ld(&(bar)[XB_TMO])) break; if (_sp > XB_SPIN_CAP) { atomicAdd(&(bar)[XB_TMO], 1u); break; } } } } while (0)

struct XcdBarrier {
    unsigned* bar; unsigned x;
    volatile LAS unsigned* st;
};

__device__ __forceinline__ XcdBarrier xcd_barrier_post(unsigned* bar, volatile LAS unsigned* st) {
    XcdBarrier b; b.bar = bar; b.x = xb_xcc_id(); b.st = st;
    if (threadIdx.x == 0) (void)xb_add(&bar[XB_XCNT(b.x)], 1u);
    return b;
}
__device__ __forceinline__ void xcd_barrier_complete(unsigned* bar, unsigned x, unsigned& nloc, unsigned& nx) {
    const unsigned G = gridDim.x * gridDim.y * gridDim.z;
    unsigned sum, cnt, mine, sp = 0u;
    for (;;) {
        sum = 0u; cnt = 0u; mine = 0u;
#pragma unroll
        for (unsigned j = 0; j < 16; ++j) { const unsigned c = xb_ld(&bar[XB_XCNT(j)]); sum += c; cnt += (c > 0u) ? 1u : 0u; mine = (j == x) ? c : mine; }
        if (sum == G) break;
        __builtin_amdgcn_s_sleep(1);
        if ((++sp & 255u) == 0u) { if (xb_ld(&bar[XB_TMO])) break; if (sp > XB_SPIN_CAP) { atomicAdd(&bar[XB_TMO], 1u); break; } }
    }
    nloc = mine > 0u ? mine : 1u; nx = cnt > 0u ? cnt : 1u;
}

__device__ __forceinline__ void xcd_barrier(const XcdBarrier& b) {
    asm volatile("s_waitcnt vmcnt(0)" ::: "memory");
    __syncthreads();
    if (threadIdx.x == 0) {
        unsigned* bar = b.bar;
        __builtin_amdgcn_s_waitcnt(0);
        unsigned nloc = b.st[0], nx = b.st[1];
        if (nloc == 0u) { xcd_barrier_complete(bar, b.x, nloc, nx); b.st[0] = nloc; b.st[1] = nx; }
        const unsigned old = xb_add(&bar[XB_XSUB(b.x)], 1u);
        const unsigned gen = old / nloc;
        if (old + 1u == (gen + 1u) * nloc) {
            __builtin_amdgcn_fence(__ATOMIC_RELEASE, "agent");
            asm volatile("s_waitcnt vmcnt(0)" ::: "memory");
            const unsigned og = xb_add(&bar[XB_TOP], 1u);
            const unsigned tg = og / nx;
            if (og + 1u == (tg + 1u) * nx) xb_add(&bar[XB_TOPGEN], 1u);
            else XB_SPIN(xb_ld(&bar[XB_TOPGEN]) == tg, bar);
            __builtin_amdgcn_fence(__ATOMIC_ACQUIRE, "agent");
            xb_add(&bar[XB_XGEN(b.x)], 1u);
            asm volatile("s_waitcnt vmcnt(0)" ::: "memory");
        } else {
            XB_SPIN(xb_ld(&bar[XB_XGEN(b.x)]) == gen, bar);
            __builtin_amdgcn_fence(__ATOMIC_ACQUIRE, "agent");
            asm volatile("s_waitcnt vmcnt(0)" ::: "memory");
        }
    }
    __syncthreads();
}
constexpr int NWAVES = 8;
constexpr int RING_BYTES = 131072;
constexpr int LDSCTL_OFF = RING_BYTES, MISC_OFF = LDSCTL_OFF + 320;
constexpr int LDS_BYTES = 147456;
struct Args { const float* in[19]; float* out; unsigned char* ws; int ph_lo, ph_hi; };
struct Frame {
    LAS unsigned char* lds; volatile LAS unsigned* MISC; unsigned* ctl;
    int tid, lane, wave, vcu, G;
    const float *x_prompt, *x_sample, *state_conv, *state_delta, *cache_k, *cache_v, *c_prompt, *c_sample, *w_ada, *b_ada, *w_in, *conv_w, *a_log, *dt_bias, *norm_a, *sinks, *w_out, *ln_g, *ln_b;
    float* out; unsigned char* ws;
};
__device__ __forceinline__ float wave_sum(float v) {
#pragma unroll
    for (int o = 1; o < 64; o <<= 1) v += __shfl_xor(v, o);
    return v;
}
__device__ __forceinline__ void p0_transpose_item(const float* W, int K, int N, int nblk, bf16_t* WT, LAS float* scr, int item, int lane) {
    const int kb = item / nblk, nb = item % nblk, k0 = 64 * kb, n0 = 32 * nb;
    const int nsrc = n0 + (lane & 31);
#pragma unroll 8
    for (int i = 0; i < 32; ++i) { const int kk = 2 * i + (lane >> 5); scr[kk * 33 + (lane & 31)] = nsrc < N ? W[(size_t)(k0 + kk) * N + nsrc] : 0.f; }
    LDS_WAIT(); asm volatile("" ::: "memory");
    const int c = lane & 7;
#pragma unroll
    for (int j = 0; j < 4; ++j) { const int n = (lane >> 3) + 8 * j; const LAS float* s = scr + (8 * c) * 33 + n;
        u32x4 o; o.x = pk2(s[0 * 33], s[1 * 33]); o.y = pk2(s[2 * 33], s[3 * 33]); o.z = pk2(s[4 * 33], s[5 * 33]); o.w = pk2(s[6 * 33], s[7 * 33]);
        *(u32x4*)(WT + (size_t)(n0 + n) * K + k0 + 8 * c) = o; }
    LDS_WAIT(); asm volatile("" ::: "memory");
}
__device__ __forceinline__ void p0_mod_unit(Frame& F, int u) {
    const int ct = u % 48, kc = u / 48;
    LAS float* cs = (LAS float*)F.lds;
    for (int e = F.tid; e < 136 * 128; e += 512) { const int r = e >> 7, k = e & 127;
        float v = 0.f; if (r < 2) v = F.c_prompt[r * 1024 + kc * 128 + k]; else if (r < 130) v = F.c_sample[(r - 2) * 1024 + kc * 128 + k]; cs[e] = v; }
    __syncthreads();
    const int col = F.tid & 63, rg = F.wave;
    float acc[17];
#pragma unroll
    for (int i = 0; i < 17; ++i) acc[i] = 0.f;
    const float* wp = F.w_ada + (size_t)(kc * 128) * 3072 + ct * 64 + col;
    for (int k = 0; k < 128; k += 4) {
        const float w0 = wp[(size_t)(k + 0) * 3072], w1 = wp[(size_t)(k + 1) * 3072], w2 = wp[(size_t)(k + 2) * 3072], w3 = wp[(size_t)(k + 3) * 3072];
#pragma unroll
        for (int i = 0; i < 17; ++i) { const f32x4 c4 = *(const LAS f32x4*)&cs[(rg + 8 * i) * 128 + k]; acc[i] = fmaf(c4.x, w0, fmaf(c4.y, w1, fmaf(c4.z, w2, fmaf(c4.w, w3, acc[i])))); }
    }
    float* slab = (float*)(F.ws + WS_SLAB) + (size_t)kc * 130 * 3072;
#pragma unroll
    for (int i = 0; i < 17; ++i) { const int r = rg + 8 * i; if (r < 130) slab[(size_t)r * 3072 + ct * 64 + col] = acc[i]; }
    __syncthreads();
}
__device__ __forceinline__ void p0_prologue(Frame& F) {
    for (int u = F.vcu; u < 384; u += F.G) p0_mod_unit(F, u);
    LAS float* scr = (LAS float*)(F.lds + F.wave * 16384);
    const int gw = F.vcu * NWAVES + F.wave, NGW = F.G * NWAVES;
    constexpr int I_IN = 16 * (PLD / 32), I_OUT = 16 * 32;
    for (int it = gw; it < I_IN + I_OUT; it += NGW) {
        if (it < I_IN) p0_transpose_item(F.w_in, 1024, PROJ_COLS, PLD / 32, (bf16_t*)(F.ws + WS_WIN), scr, it, F.lane);
        else p0_transpose_item(F.w_out, 1024, 1024, 32, (bf16_t*)(F.ws + WS_WOUT), scr, it - I_IN, F.lane);
    }
    float* ct = (float*)(F.ws + WS_ROPE); float* st = ct + 8193 * 32;
    for (int e = F.vcu * 512 + F.tid; e < 8193 * 32; e += F.G * 512) { float c, s; rope_cs(e >> 5, e & 31, c, s); ct[e] = c; st[e] = s; }
}
__device__ __forceinline__ void p1_h(Frame& F) {
    LAS float* ms = (LAS float*)F.lds;
    const float* slab = (const float*)(F.ws + WS_SLAB);
    for (int e = F.tid; e < 4096; e += 512) { const int b = e >> 11, c = e & 2047; float s = F.b_ada[c];
#pragma unroll
        for (int kc = 0; kc < 8; ++kc) s += slab[((size_t)kc * 130 + b) * 3072 + c];
        ms[e] = s; }
    float* mod = (float*)(F.ws + WS_MOD);
    for (int e = F.vcu * 512 + F.tid; e < 130 * 3072; e += F.G * 512) { const int c = e % 3072; float s = F.b_ada[c];
#pragma unroll
        for (int kc = 0; kc < 8; ++kc) s += slab[(size_t)kc * 130 * 3072 + e];
        mod[e] = s; }
    __syncthreads();
    bf16_t* h = (bf16_t*)(F.ws + WS_H);
    const int gw = F.vcu * NWAVES + F.wave, NGW = F.G * NWAVES;
    for (int row = gw; row < MPAD; row += NGW) {
        u32x2* o8 = (u32x2*)(h + (size_t)row * 1024) + F.lane;
        if (row >= MT) {
#pragma unroll
            for (int j = 0; j < 4; ++j) o8[64 * j] = (u32x2){0u, 0u};
            continue; }
        const float* xr = row < MP ? F.x_prompt + (size_t)row * 1024 : F.x_sample + (size_t)(row - MP) * 1024;
#pragma unroll
        for (int j = 0; j < 4; ++j) {
            const int c = 4 * F.lane + 256 * j;
            const f32x4 xv = *(const f32x4*)(xr + c);
            f32x4 sh, sc;
            if (row < MP) { const int b = row >> 13; sh = *(const LAS f32x4*)&ms[b * 2048 + c]; sc = *(const LAS f32x4*)&ms[b * 2048 + 1024 + c]; }
            else { const int r = 2 + row - MP; sh = *(const f32x4*)(F.b_ada + c); sc = *(const f32x4*)(F.b_ada + 1024 + c);
#pragma unroll
                for (int kc = 0; kc < 8; ++kc) { sh += *(const f32x4*)(slab + ((size_t)kc * 130 + r) * 3072 + c); sc += *(const f32x4*)(slab + ((size_t)kc * 130 + r) * 3072 + 1024 + c); } }
            const f32x4 hv = xv * (sc + 1.0f) + sh;
            o8[64 * j] = (u32x2){pk2(hv.x, hv.y), pk2(hv.z, hv.w)};
        }
    }
}
constexpr size_t WS_QF = WS_X, WS_OF = WS_X + 16 * MiB, WS_SF = WS_X + 32 * MiB, WS_GL = 27 * MiB;
constexpr int E1_SQ = 136, E1_ST = 72;
constexpr int E1_QS = 0, E1_KS = 17408, E1_KT = 35840, E1_VT = 54272, E1_LF = 72704, E1_T1 = 91136, E1_T2 = 100352, E1_AQ = 109568, E1_YT = 118784, E1_SM = 123008;
constexpr int E1_LL = 68;
__device__ __forceinline__ bf16x8 lds_frag(const LAS unsigned char* base, int stride_el, int row0, int ks, int lane) {
    return *(const LAS bf16x8*)(base + ((row0 + (lane & 15)) * stride_el + 32 * ks + 8 * (lane >> 4)) * 2);
}
#define MFMA16(a, b, c) __builtin_amdgcn_mfma_f32_16x16x32_bf16((a), (b), (c), 0, 0, 0)
__device__ __forceinline__ void wg_barrier() { asm volatile("s_waitcnt vmcnt(0) lgkmcnt(0)" ::: "memory"); __builtin_amdgcn_s_barrier(); asm volatile("" ::: "memory"); }
__device__ __forceinline__ void lds_barrier() { asm volatile("s_waitcnt lgkmcnt(0)" ::: "memory"); __builtin_amdgcn_s_barrier(); asm volatile("" ::: "memory"); }

__device__ __forceinline__ void e1_item(Frame& F, int cidx) {
    const int tid = F.tid, lane = F.lane, w = F.wave, q4 = lane >> 4, c16 = lane & 15;
    const int bh = cidx >> 7, ch = cidx & 127, b = bh >> 2, hd = bh & 3;
    const bf16_t* proj = (const bf16_t*)(F.ws + WS_PROJ);
    const size_t rbase = (size_t)b * SEQ + (size_t)ch * 64;
    LAS unsigned char* L = F.lds;
    LAS float* SM = (LAS float*)(L + E1_SM);
    if (w == 0) {
        const float pb = bf2f(proj[(rbase + lane) * PLD + OFF_A_BETA + hd]), pd = bf2f(proj[(rbase + lane) * PLD + OFF_A_DECAY + hd]);
        const float bt = sigmoidf_(pb);
        float G = -__expf(F.a_log[hd]) * softplusf_(pd + F.dt_bias[hd]);
#pragma unroll
        for (int o = 1; o < 64; o <<= 1) { const float t = __shfl_up(G, o); if (lane >= o) G += t; }
        const float Glast = __shfl(G, 63);
        const float eg = __expf(G);
        SM[lane] = G; SM[64 + lane] = bt; SM[128 + lane] = eg; SM[192 + lane] = __expf(Glast - G); SM[256 + lane] = bt * eg;
        if (lane == 63) ((float*)(F.ws + WS_GL))[cidx] = eg;
    }
    {
        const int cg = tid & 15, tp = tid >> 4;
#pragma unroll
        for (int part = 0; part < 3; ++part) {
            const int col0 = part * 512 + hd * 128 + 8 * cg;
            float wj[4][8];
#pragma unroll
            for (int j = 0; j < 4; ++j) { const f32x4 a = *(const f32x4*)(F.conv_w + j * A_QKV + col0), bq = *(const f32x4*)(F.conv_w + j * A_QKV + col0 + 4);
                wj[j][0] = a.x; wj[j][1] = a.y; wj[j][2] = a.z; wj[j][3] = a.w; wj[j][4] = bq.x; wj[j][5] = bq.y; wj[j][6] = bq.z; wj[j][7] = bq.w; }
            float rows[5][8];
#pragma unroll
            for (int i = 0; i < 5; ++i) {
                const int tl = ch * 64 + 2 * tp - 3 + i;
                bf16x8 v = (bf16x8){0, 0, 0, 0, 0, 0, 0, 0};
                if (tl >= 0) v = *(const bf16x8*)(proj + ((size_t)b * SEQ + tl) * PLD + col0);
#pragma unroll
                for (int e = 0; e < 8; ++e) rows[i][e] = bf2f((bf16_t)v[e]);
            }
            if (ch == 127 && tp == 31) {
#pragma unroll
                for (int i = 0; i < 3; ++i)
#pragma unroll
                    for (int e = 0; e < 8; ++e) F.out[O_CONVP + ((size_t)b * 3 + i) * A_QKV + col0 + e] = rows[2 + i][e];
            }
            float val[2][8]; float ss[2] = {0.f, 0.f};
#pragma unroll
            for (int tt = 0; tt < 2; ++tt)
#pragma unroll
                for (int e = 0; e < 8; ++e) { float a = 0.f;
#pragma unroll
                    for (int j = 0; j < 4; ++j) a = fmaf(rows[tt + j][e], wj[j][e], a);
                    a = siluf(a); val[tt][e] = a; ss[tt] = fmaf(a, a, ss[tt]); }
            if (part < 2) {
#pragma unroll
                for (int tt = 0; tt < 2; ++tt) {
                    float s = ss[tt]; s += __shfl_xor(s, 1); s += __shfl_xor(s, 2); s += __shfl_xor(s, 4); s += __shfl_xor(s, 8);
                    const float sc = rsqrtf(s + L2_EPS) * (part == 0 ? 0.08838834764831845f : 1.f);
#pragma unroll
                    for (int e = 0; e < 8; ++e) val[tt][e] *= sc;
                }
            }
            if (part < 2) {
                LAS unsigned char* dst = L + (part == 0 ? E1_QS : E1_KS);
#pragma unroll
                for (int tt = 0; tt < 2; ++tt) { u32x4 o; o.x = pk2(val[tt][0], val[tt][1]); o.y = pk2(val[tt][2], val[tt][3]); o.z = pk2(val[tt][4], val[tt][5]); o.w = pk2(val[tt][6], val[tt][7]);
                    *(LAS u32x4*)(dst + ((2 * tp + tt) * E1_SQ + 8 * cg) * 2) = o; }
            }
            if (part >= 1) {
                LAS unsigned char* dst = L + (part == 1 ? E1_KT : E1_VT);
#pragma unroll
                for (int e = 0; e < 8; ++e) *(LAS unsigned*)(dst + ((8 * cg + e) * E1_ST + 2 * tp) * 2) = pk2(val[0][e], val[1][e]);
            }
        }
    }
    lds_barrier();
    {
        LAS float* Lf = (LAS float*)(L + E1_LF);
#pragma unroll 1
        for (int jb = w; jb < 32; jb += 8) {
            const int which = jb >> 4, mi = (jb >> 2) & 3, ni = jb & 3;
            f32x4 acc = (f32x4){0.f, 0.f, 0.f, 0.f};
            if (ni <= mi) {
#pragma unroll
                for (int ks = 0; ks < 4; ++ks) acc = MFMA16(lds_frag(L + (which ? E1_QS : E1_KS), E1_SQ, 16 * mi, ks, lane), lds_frag(L + E1_KS, E1_SQ, 16 * ni, ks, lane), acc);
            }
            const int i = 16 * ni + c16; const float Gi = SM[i];
#pragma unroll
            for (int r = 0; r < 4; ++r) {
                const int t = 16 * mi + 4 * q4 + r; const float Gt = SM[t];
                const float dec = __expf(fminf(Gt - Gi, 0.f));
                if (which == 0) Lf[t * E1_LL + i] = (t > i) ? SM[64 + t] * acc[r] * dec : 0.f;
                else *(LAS bf16_t*)(L + E1_AQ + (t * E1_ST + i) * 2) = f2bf((t >= i) ? acc[r] * dec : 0.f);
            }
        }
    }
    lds_barrier();
    {
        LAS float* Lf = (LAS float*)(L + E1_LF); LAS float* Yt = (LAS float*)(L + E1_YT);
        if (w == 0) {
            const int bb = lane >> 4, j = lane & 15;
            float x[16];
#pragma unroll
            for (int t = 0; t < 16; ++t) { float a = (t == j) ? 1.f : 0.f;
#pragma unroll
                for (int i = 0; i < t; ++i) a = fmaf(-Lf[(16 * bb + t) * E1_LL + 16 * bb + i], x[i], a);
                x[t] = a; }
            asm volatile("s_waitcnt lgkmcnt(0)" ::: "memory");
#pragma unroll
            for (int t = 0; t < 16; ++t) Lf[(16 * bb + t) * E1_LL + 16 * bb + j] = x[t];
        }
        lds_barrier();
        {
            const int p = tid >> 8, r = (tid >> 4) & 15, c = tid & 15, a = 32 * p;
            float y = 0.f;
#pragma unroll
            for (int k = 0; k < 16; ++k) y = fmaf(Lf[(a + 16 + r) * E1_LL + a + k], Lf[(a + k) * E1_LL + a + c], y);
            Yt[p * 16 * 33 + r * 33 + c] = y;
            lds_barrier();
            float pv = 0.f;
#pragma unroll
            for (int k = 0; k < 16; ++k) pv = fmaf(Lf[(a + 16 + r) * E1_LL + a + 16 + k], Yt[p * 16 * 33 + k * 33 + c], pv);
            lds_barrier();
            Lf[(a + 16 + r) * E1_LL + a + c] = -pv;
        }
        lds_barrier();
        {
            float y[2], pv[2];
#pragma unroll
            for (int u = 0; u < 2; ++u) { const int o = tid + 512 * u, r = o >> 5, c = o & 31; float s = 0.f;
#pragma unroll 8
                for (int k = 0; k < 32; ++k) s = fmaf(Lf[(32 + r) * E1_LL + k], Lf[k * E1_LL + c], s);
                y[u] = s; }
#pragma unroll
            for (int u = 0; u < 2; ++u) { const int o = tid + 512 * u; Yt[(o >> 5) * 33 + (o & 31)] = y[u]; }
            lds_barrier();
#pragma unroll
            for (int u = 0; u < 2; ++u) { const int o = tid + 512 * u, r = o >> 5, c = o & 31; float s = 0.f;
#pragma unroll 8
                for (int k = 0; k < 32; ++k) s = fmaf(Lf[(32 + r) * E1_LL + 32 + k], Yt[k * 33 + c], s);
                pv[u] = s; }
            lds_barrier();
#pragma unroll
            for (int u = 0; u < 2; ++u) { const int o = tid + 512 * u; Lf[(32 + (o >> 5)) * E1_LL + (o & 31)] = -pv[u]; }
        }
        lds_barrier();
#pragma unroll
        for (int u = 0; u < 8; ++u) { const int o = tid + 512 * u, t = o >> 6, i = o & 63; const float tv = Lf[t * E1_LL + i];
            *(LAS bf16_t*)(L + E1_T1 + (t * E1_ST + i) * 2) = f2bf(tv * SM[256 + i]); *(LAS bf16_t*)(L + E1_T2 + (t * E1_ST + i) * 2) = f2bf(tv * SM[64 + i]); }
    }
    lds_barrier();
    {
#pragma unroll 1
        for (int jb = w; jb < 64; jb += 8) {
            const int which = jb >> 5, mi = (jb >> 3) & 3, ni = jb & 7;
            f32x4 acc = (f32x4){0.f, 0.f, 0.f, 0.f};
#pragma unroll
            for (int ks = 0; ks < 2; ++ks) acc = MFMA16(lds_frag(L + (which ? E1_T2 : E1_T1), E1_ST, 16 * mi, ks, lane), lds_frag(L + (which ? E1_VT : E1_KT), E1_ST, 16 * ni, ks, lane), acc);
            *(LAS u32x2*)(L + (which ? E1_LF : E1_KS) + ((16 * ni + c16) * E1_ST + 16 * mi + 4 * q4) * 2) = (u32x2){pk2(acc[0], acc[1]), pk2(acc[2], acc[3])};
        }
    }
    lds_barrier();
    {
        const int d = tid >> 2, t0 = (tid & 3) * 16;
        LAS bf16_t* p = (LAS bf16_t*)(L + E1_KT) + d * E1_ST + t0;
#pragma unroll
        for (int e = 0; e < 16; ++e) p[e] = f2bf(bf2f(p[e]) * SM[192 + t0 + e]);
    }
    lds_barrier();
    {
        const LAS unsigned char* WT = L + E1_KS; const LAS unsigned char* UT = L + E1_LF; const LAS unsigned char* KdT = L + E1_KT; const LAS unsigned char* AQ = L + E1_AQ;
        bf16_t* MF = (bf16_t*)F.out + (size_t)cidx * 16384;
        bf16_t* BF = (bf16_t*)((unsigned char*)F.out + 32 * MiB) + (size_t)cidx * 16384;
        bf16_t* QF = (bf16_t*)(F.ws + WS_QF) + (size_t)cidx * 8192;
        bf16_t* OFp = (bf16_t*)(F.ws + WS_OF) + (size_t)cidx * 8192;
        {
            const bf16x8 b0 = lds_frag(KdT, E1_ST, 16 * w, 0, lane), b1 = lds_frag(KdT, E1_ST, 16 * w, 1, lane);
#pragma unroll
            for (int kp = 0; kp < 4; ++kp) {
                f32x4 a0 = (f32x4){0.f, 0.f, 0.f, 0.f}, a1 = a0;
                a0 = MFMA16(lds_frag(WT, E1_ST, 16 * (2 * kp), 0, lane), b0, a0); a0 = MFMA16(lds_frag(WT, E1_ST, 16 * (2 * kp), 1, lane), b1, a0);
                a1 = MFMA16(lds_frag(WT, E1_ST, 16 * (2 * kp + 1), 0, lane), b0, a1); a1 = MFMA16(lds_frag(WT, E1_ST, 16 * (2 * kp + 1), 1, lane), b1, a1);
                *(u32x4*)(MF + ((size_t)(w * 4 + kp) * 64 + lane) * 8) = (u32x4){pk2(-a0[0], -a0[1]), pk2(-a0[2], -a0[3]), pk2(-a1[0], -a1[1]), pk2(-a1[2], -a1[3])};
            }
        }
        {
            const bf16x8 b0 = lds_frag(UT, E1_ST, 16 * w, 0, lane), b1 = lds_frag(UT, E1_ST, 16 * w, 1, lane);
#pragma unroll
            for (int kp = 0; kp < 4; ++kp) {
                f32x4 a0 = (f32x4){0.f, 0.f, 0.f, 0.f}, a1 = a0;
                a0 = MFMA16(lds_frag(KdT, E1_ST, 16 * (2 * kp), 0, lane), b0, a0); a0 = MFMA16(lds_frag(KdT, E1_ST, 16 * (2 * kp), 1, lane), b1, a0);
                a1 = MFMA16(lds_frag(KdT, E1_ST, 16 * (2 * kp + 1), 0, lane), b0, a1); a1 = MFMA16(lds_frag(KdT, E1_ST, 16 * (2 * kp + 1), 1, lane), b1, a1);
                *(u32x4*)(BF + ((size_t)(w * 64 + lane) * 8 + 2 * kp) * 4) = (u32x4){pk2(a0[0], a0[1]), pk2(a0[2], a0[3]), pk2(a1[0], a1[1]), pk2(a1[2], a1[3])};
            }
#pragma unroll
            for (int kp = 0; kp < 2; ++kp) {
                f32x4 a0 = (f32x4){0.f, 0.f, 0.f, 0.f}, a1 = a0;
                a0 = MFMA16(lds_frag(AQ, E1_ST, 16 * (2 * kp), 0, lane), b0, a0); a0 = MFMA16(lds_frag(AQ, E1_ST, 16 * (2 * kp), 1, lane), b1, a0);
                a1 = MFMA16(lds_frag(AQ, E1_ST, 16 * (2 * kp + 1), 0, lane), b0, a1); a1 = MFMA16(lds_frag(AQ, E1_ST, 16 * (2 * kp + 1), 1, lane), b1, a1);
                *(u32x4*)(OFp + ((size_t)(w * 64 + lane) * 4 + 2 * kp) * 4) = (u32x4){pk2(a0[0], a0[1]), pk2(a0[2], a0[3]), pk2(a1[0], a1[1]), pk2(a1[2], a1[3])};
            }
        }
        {
            const int ni = w & 3, t = 16 * ni + c16; const float eg = SM[128 + t];
            const bf16x8 b0 = lds_frag(AQ, E1_ST, 16 * ni, 0, lane), b1 = lds_frag(AQ, E1_ST, 16 * ni, 1, lane);
#pragma unroll
            for (int kk = 0; kk < 2; ++kk) {
                const int ks = 2 * (w >> 2) + kk;
                f32x4 a0 = (f32x4){0.f, 0.f, 0.f, 0.f}, a1 = a0;
                a0 = MFMA16(lds_frag(WT, E1_ST, 16 * (2 * ks), 0, lane), b0, a0); a0 = MFMA16(lds_frag(WT, E1_ST, 16 * (2 * ks), 1, lane), b1, a0);
                a1 = MFMA16(lds_frag(WT, E1_ST, 16 * (2 * ks + 1), 0, lane), b0, a1); a1 = MFMA16(lds_frag(WT, E1_ST, 16 * (2 * ks + 1), 1, lane), b1, a1);
                const u32x2 q0 = *(const LAS u32x2*)(L + E1_QS + (t * E1_SQ + 16 * (2 * ks) + 4 * q4) * 2), q1 = *(const LAS u32x2*)(L + E1_QS + (t * E1_SQ + 16 * (2 * ks + 1) + 4 * q4) * 2);
                const float v0 = eg * __uint_as_float(q0.x << 16) - a0[0], v1 = eg * __uint_as_float(q0.x & 0xffff0000u) - a0[1], v2 = eg * __uint_as_float(q0.y << 16) - a0[2], v3 = eg * __uint_as_float(q0.y & 0xffff0000u) - a0[3];
                const float v4 = eg * __uint_as_float(q1.x << 16) - a1[0], v5 = eg * __uint_as_float(q1.x & 0xffff0000u) - a1[1], v6 = eg * __uint_as_float(q1.y << 16) - a1[2], v7 = eg * __uint_as_float(q1.y & 0xffff0000u) - a1[3];
                *(u32x4*)(QF + ((size_t)(ni * 4 + ks) * 64 + lane) * 8) = (u32x4){pk2(v0, v1), pk2(v2, v3), pk2(v4, v5), pk2(v6, v7)};
            }
        }
    }
    wg_barrier();
}

__device__ __forceinline__ void scan_unit(Frame& F, int bh, int s) {
    const int lane = F.lane, i = F.wave;
    LAS unsigned char* L = F.lds;
    const bf16_t* MF = (const bf16_t*)F.out; const bf16_t* BF = (const bf16_t*)((unsigned char*)F.out + 32 * MiB);
    bf16_t* SF = (bf16_t*)(F.ws + WS_SF); const float* GL = (const float*)(F.ws + WS_GL);
    for (int e = F.tid; e < 2048; e += 512) ((LAS unsigned*)L)[e] = 0u;
    f32x4 acc = (f32x4){0.f, 0.f, 0.f, 0.f};
    const size_t c0 = (size_t)bh * 128;
    constexpr int PF = 4;
    bf16x8 A[PF][4]; u32x2 Bc[PF]; float gl[PF];
#define SCAN_LOAD(slot, cc) do { const size_t ci_ = c0 + (cc); _Pragma("unroll") for (int ks = 0; ks < 4; ++ks) A[slot][ks] = *(const bf16x8*)(MF + ((ci_ * 8 + i) * 4 + ks) * 512 + lane * 8); \
        Bc[slot] = *(const u32x2*)(BF + ((ci_ * 8 + s) * 64 + lane) * 32 + i * 4); gl[slot] = GL[ci_]; } while (0)
#pragma unroll
    for (int p = 0; p < PF; ++p) SCAN_LOAD(p, p);
    lds_barrier();
    for (int cb = 0; cb < 128; cb += PF) {
#pragma unroll
        for (int p = 0; p < PF; ++p) {
            const int c = cb + p, cur = p & 1;
            const size_t ci = c0 + c;
            bf16x8 Sf[4];
#pragma unroll
            for (int ks = 0; ks < 4; ++ks) Sf[ks] = *(const LAS bf16x8*)(L + cur * 4096 + (ks * 64 + lane) * 16);
            if (i < 4) *(bf16x8*)(SF + ((ci * 8 + s) * 4 + i) * 512 + lane * 8) = *(const LAS bf16x8*)(L + cur * 4096 + (i * 64 + lane) * 16);
            const float g = gl[p];
            acc[0] = fmaf(g, acc[0], __uint_as_float(Bc[p].x << 16)); acc[1] = fmaf(g, acc[1], __uint_as_float(Bc[p].x & 0xffff0000u));
            acc[2] = fmaf(g, acc[2], __uint_as_float(Bc[p].y << 16)); acc[3] = fmaf(g, acc[3], __uint_as_float(Bc[p].y & 0xffff0000u));
#pragma unroll
            for (int ks = 0; ks < 4; ++ks) acc = MFMA16(A[p][ks], Sf[ks], acc);
            *(LAS u32x2*)(L + (cur ^ 1) * 4096 + ((i >> 1) * 64 + lane) * 16 + (i & 1) * 8) = (u32x2){pk2(acc[0], acc[1]), pk2(acc[2], acc[3])};
            if (c + PF < 128) SCAN_LOAD(p, c + PF);
            lds_barrier();
        }
    }
#undef SCAN_LOAD
    float* dp = F.out + O_DELTAP + (size_t)bh * 128 * 128;
#pragma unroll
    for (int r = 0; r < 4; ++r) dp[(size_t)(16 * i + 4 * (lane >> 4) + r) * 128 + 16 * s + (lane & 15)] = acc[r];
    wg_barrier();
}

__device__ __forceinline__ void o_item(Frame& F, int cidx) {
    const int tid = F.tid, lane = F.lane, w = F.wave, q4 = lane >> 4, c16 = lane & 15;
    const int bh = cidx >> 7, ch = cidx & 127, b = bh >> 2, hd = bh & 3;
    const bf16_t* QF = (const bf16_t*)(F.ws + WS_QF) + (size_t)cidx * 8192; const bf16_t* OFp = (const bf16_t*)(F.ws + WS_OF) + (size_t)cidx * 8192;
    const bf16_t* SF = (const bf16_t*)(F.ws + WS_SF) + (size_t)cidx * 16384;
    LAS float* Of = (LAS float*)F.lds;
    bf16x8 Sf[4];
#pragma unroll
    for (int ks = 0; ks < 4; ++ks) Sf[ks] = *(const bf16x8*)(SF + ((size_t)(w * 4 + ks) * 64 + lane) * 8);
    const u32x4 o01 = *(const u32x4*)(OFp + ((size_t)(w * 64 + lane) * 4) * 4), o23 = *(const u32x4*)(OFp + ((size_t)(w * 64 + lane) * 4 + 2) * 4);
    const unsigned ow[8] = {o01.x, o01.y, o01.z, o01.w, o23.x, o23.y, o23.z, o23.w};
#pragma unroll
    for (int mt = 0; mt < 4; ++mt) {
        f32x4 acc = (f32x4){__uint_as_float(ow[2 * mt] << 16), __uint_as_float(ow[2 * mt] & 0xffff0000u), __uint_as_float(ow[2 * mt + 1] << 16), __uint_as_float(ow[2 * mt + 1] & 0xffff0000u)};
#pragma unroll
        for (int ks = 0; ks < 4; ++ks) acc = MFMA16(*(const bf16x8*)(QF + ((size_t)(mt * 4 + ks) * 64 + lane) * 8), Sf[ks], acc);
#pragma unroll
        for (int r = 0; r < 4; ++r) Of[(16 * mt + 4 * q4 + r) * 132 + 16 * w + c16] = acc[r];
    }
    lds_barrier();
    {
        const int t = tid >> 3, cs = tid & 7;
        float v[16]; float ss = 0.f;
#pragma unroll
        for (int u = 0; u < 4; ++u) { const f32x4 x = *(const LAS f32x4*)&Of[t * 132 + 16 * cs + 4 * u]; v[4 * u] = x.x; v[4 * u + 1] = x.y; v[4 * u + 2] = x.z; v[4 * u + 3] = x.w; ss += x.x * x.x + x.y * x.y + x.z * x.z + x.w * x.w; }
        ss += __shfl_xor(ss, 1); ss += __shfl_xor(ss, 2); ss += __shfl_xor(ss, 4);
        const float rs = rsqrtf(ss * (1.f / 128.f) + RMS_EPS);
        const size_t row = (size_t)b * SEQ + (size_t)ch * 64 + t;
        const bf16_t* zp = (const bf16_t*)(F.ws + WS_PROJ) + row * PLD + OFF_A_Z + hd * 128 + 16 * cs;
        const bf16x8 z0 = *(const bf16x8*)zp, z1 = *(const bf16x8*)(zp + 8);
        float o[16];
#pragma unroll
        for (int e = 0; e < 16; ++e) { const float z = bf2f((bf16_t)(e < 8 ? z0[e] : z1[e - 8])); o[e] = v[e] * rs * F.norm_a[16 * cs + e] * siluf(z); }
        bf16_t* mp = (bf16_t*)(F.ws + WS_H) + row * 1024 + hd * 128 + 16 * cs;
        *(u32x4*)mp = (u32x4){pk2(o[0], o[1]), pk2(o[2], o[3]), pk2(o[4], o[5]), pk2(o[6], o[7])};
        *(u32x4*)(mp + 8) = (u32x4){pk2(o[8], o[9]), pk2(o[10], o[11]), pk2(o[12], o[13]), pk2(o[14], o[15])};
    }
    wg_barrier();
}
__global__ void __launch_bounds__(128) k_convA(const bf16_t* __restrict__ proj, const float* __restrict__ state_conv, const float* __restrict__ conv_w,
                                               const float* __restrict__ a_log, const float* __restrict__ dt_bias,
                                               float* __restrict__ qa, float* __restrict__ ka, float* __restrict__ va, float* __restrict__ beta, float* __restrict__ g, int row0) {
    const int r = row0 + blockIdx.x, hd = blockIdx.y, c = threadIdx.x;
    __shared__ float red[2][128];
    float vals[3];
#pragma unroll
    for (int part = 0; part < 3; ++part) {
        const int col = part * A_WIDTH + hd * 128 + c;
        float acc = 0.f;
#pragma unroll
        for (int j = 0; j < 4; ++j) {
            float u;
            if (r < MP) { const int t = r % SEQ, tt = t - 3 + j; u = tt >= 0 ? bf2f(proj[(size_t)(r - 3 + j) * PLD + col]) : 0.f; }
            else { const int b = r - MP; u = j < 3 ? state_conv[((size_t)b * 3 + j) * A_QKV + col] : bf2f(proj[(size_t)r * PLD + col]); }
            acc = fmaf(u, conv_w[j * A_QKV + col], acc);
        }
        vals[part] = siluf(acc);
    }
    red[0][c] = vals[0] * vals[0]; red[1][c] = vals[1] * vals[1];
    __syncthreads();
    for (int s = 64; s > 0; s >>= 1) { if (c < s) { red[0][c] += red[0][c + s]; red[1][c] += red[1][c + s]; } __syncthreads(); }
    const float rq = rsqrtf(red[0][0] + L2_EPS) * 0.08838834764831845f, rk = rsqrtf(red[1][0] + L2_EPS);
    const size_t o = (size_t)blockIdx.x * A_WIDTH + hd * 128 + c;
    qa[o] = vals[0] * rq; ka[o] = vals[1] * rk; va[o] = vals[2];
    if (c == 0) {
        beta[(size_t)blockIdx.x * 4 + hd] = sigmoidf_(bf2f(proj[(size_t)r * PLD + OFF_A_BETA + hd]));
        g[(size_t)blockIdx.x * 4 + hd] = -__expf(a_log[hd]) * softplusf_(bf2f(proj[(size_t)r * PLD + OFF_A_DECAY + hd]) + dt_bias[hd]);
    }
}

__global__ void k_conv_state(const bf16_t* __restrict__ proj, const float* __restrict__ state_conv, float* __restrict__ out) {
    const int i = blockIdx.x * blockDim.x + threadIdx.x;
    if (i < BATCH * 3 * A_QKV) { const int b = i / (3 * A_QKV), j = (i / A_QKV) % 3, c = i % A_QKV; out[O_CONVP + i] = bf2f(proj[(size_t)(b * SEQ + SEQ - 3 + j) * PLD + c]); }
    if (i < DEC_BATCH * 3 * A_QKV) { const int b = i / (3 * A_QKV), j = (i / A_QKV) % 3, c = i % A_QKV;
        out[O_CONVS + i] = j < 2 ? state_conv[((size_t)b * 3 + j + 1) * A_QKV + c] : bf2f(proj[(size_t)(MP + b) * PLD + c]); }
}

__global__ void __launch_bounds__(128) k_delta_rec(const float* __restrict__ qa, const float* __restrict__ ka, const float* __restrict__ va, const float* __restrict__ beta, const float* __restrict__ g,
                                                   const float* __restrict__ s0, float* __restrict__ s_out, float* __restrict__ oa, int row0, int T) {
    const int seq = blockIdx.x >> 2, hd = blockIdx.x & 3, e = threadIdx.x;
    __shared__ float kq[2][128];
    float S[128];
    const size_t sbase = ((size_t)(seq * 4 + hd) * 128) * 128 + e;
#pragma unroll
    for (int d = 0; d < 128; ++d) S[d] = s0 ? s0[sbase + (size_t)d * 128] : 0.f;
    for (int t = 0; t < T; ++t) {
        const size_t r = (size_t)row0 + (size_t)seq * T + t;
        __syncthreads();
        kq[0][e] = ka[r * A_WIDTH + hd * 128 + e]; kq[1][e] = qa[r * A_WIDTH + hd * 128 + e];
        __syncthreads();
        const float dec = __expf(g[r * 4 + hd]), bt = beta[r * 4 + hd], v = va[r * A_WIDTH + hd * 128 + e];
        float pred = 0.f;
#pragma unroll
        for (int d = 0; d < 128; ++d) { S[d] *= dec; pred = fmaf(kq[0][d], S[d], pred); }
        const float u = bt * (v - pred);
        float o = 0.f;
#pragma unroll
        for (int d = 0; d < 128; ++d) { S[d] = fmaf(kq[0][d], u, S[d]); o = fmaf(kq[1][d], S[d], o); }
        oa[r * A_WIDTH + hd * 128 + e] = o;
    }
#pragma unroll
    for (int d = 0; d < 128; ++d) s_out[sbase + (size_t)d * 128] = S[d];
}

__global__ void __launch_bounds__(128) k_rms_gate(const float* __restrict__ oa, const bf16_t* __restrict__ proj, const float* __restrict__ norm_a, bf16_t* __restrict__ mix, int row0) {
    const int r = row0 + blockIdx.x, hd = blockIdx.y, e = threadIdx.x;
    __shared__ float red[128];
    const float o = oa[(size_t)blockIdx.x * A_WIDTH + hd * 128 + e];
    red[e] = o * o; __syncthreads();
    for (int s = 64; s > 0; s >>= 1) { if (e < s) red[e] += red[e + s]; __syncthreads(); }
    const float rs = rsqrtf(red[0] * (1.f / 128.f) + RMS_EPS);
    const float z = bf2f(proj[(size_t)r * PLD + OFF_A_Z + hd * 128 + e]);
    mix[(size_t)r * 1024 + hd * 128 + e] = f2bf(o * rs * norm_a[e] * siluf(z));
}

__global__ void k_rope(const bf16_t* __restrict__ proj, float* __restrict__ qb, float* __restrict__ kb, float* __restrict__ vb) {
    const int r = blockIdx.x;
    const int pos = r < MP ? r % SEQ : PAST_LEN;
    for (int idx = threadIdx.x; idx < 10 * 32; idx += blockDim.x) {
        const int hh = idx >> 5, i = idx & 31;
        float c, s; rope_cs(pos, i, c, s);
        if (hh < 8) {
            const float x1 = bf2f(proj[(size_t)r * PLD + OFF_B_Q + hh * 64 + i]), x2 = bf2f(proj[(size_t)r * PLD + OFF_B_Q + hh * 64 + 32 + i]);
            qb[(size_t)r * 512 + hh * 64 + i] = (x1 * c - x2 * s) * 0.125f; qb[(size_t)r * 512 + hh * 64 + 32 + i] = (x2 * c + x1 * s) * 0.125f;
        } else {
            const int kh = hh - 8;
            const float x1 = bf2f(proj[(size_t)r * PLD + OFF_B_K + kh * 64 + i]), x2 = bf2f(proj[(size_t)r * PLD + OFF_B_K + kh * 64 + 32 + i]);
            kb[(size_t)r * 128 + kh * 64 + i] = x1 * c - x2 * s; kb[(size_t)r * 128 + kh * 64 + 32 + i] = x2 * c + x1 * s;
        }
    }
    for (int idx = threadIdx.x; idx < 128; idx += blockDim.x) vb[(size_t)r * 128 + idx] = bf2f(proj[(size_t)r * PLD + OFF_B_V + idx]);
}
__global__ void k_cache_out(const float* __restrict__ kb, const float* __restrict__ vb, const float* __restrict__ ck, const float* __restrict__ cv, float* __restrict__ out) {
    const int i = blockIdx.x * blockDim.x + threadIdx.x;
    if (i < BATCH * WINDOW * 128) { const int b = i / (WINDOW * 128), w = (i / 128) % WINDOW, c = i % 128; const size_t r = (size_t)b * SEQ + SEQ - WINDOW + w;
        out[O_KP + i] = kb[r * 128 + c]; out[O_VP + i] = vb[r * 128 + c]; }
    if (i < DEC_BATCH * WINDOW * 128) { const int b = i / (WINDOW * 128), w = (i / 128) % WINDOW, c = i % 128;
        out[O_KS + i] = w < WINDOW - 1 ? ck[((size_t)b * WINDOW + w + 1) * 128 + c] : kb[(size_t)(MP + b) * 128 + c];
        out[O_VS + i] = w < WINDOW - 1 ? cv[((size_t)b * WINDOW + w + 1) * 128 + c] : vb[(size_t)(MP + b) * 128 + c]; }
}

__global__ void __launch_bounds__(64) k_swa(const float* __restrict__ qb, const float* __restrict__ kb, const float* __restrict__ vb, const float* __restrict__ ck, const float* __restrict__ cv,
                                           const float* __restrict__ sinks, const bf16_t* __restrict__ proj, bf16_t* __restrict__ mix) {
    const int r = blockIdx.x, hh = blockIdx.y, kvh = hh >> 2, lane = threadIdx.x;
    __shared__ float qs[64];
    __shared__ float ps[192];
    qs[lane] = qb[(size_t)r * 512 + hh * 64 + lane];
    __syncthreads();
    int nk;
    const bool prompt = r < MP;
    int t = 0, b = 0;
    if (prompt) { t = r % SEQ; b = r / SEQ; nk = t < WINDOW ? t + 1 : WINDOW + 1; } else { b = r - MP; nk = WINDOW + 1; }
    float sc[3]; float mx = -INFINITY;
#pragma unroll
    for (int i = 0; i < 3; ++i) {
        const int j = lane + 64 * i; sc[i] = -INFINITY;
        if (j < nk) {
            const float* kp;
            if (prompt) kp = kb + ((size_t)b * SEQ + (t - nk + 1 + j)) * 128 + kvh * 64;
            else kp = j < WINDOW ? ck + ((size_t)b * WINDOW + j) * 128 + kvh * 64 : kb + (size_t)r * 128 + kvh * 64;
            float a = 0.f;
            for (int d = 0; d < 64; ++d) a = fmaf(qs[d], kp[d], a);
            sc[i] = a; mx = fmaxf(mx, a);
        }
    }
    for (int o = 32; o > 0; o >>= 1) mx = fmaxf(mx, __shfl_xor(mx, o));
    const float sink = sinks[hh];
    mx = fmaxf(mx, sink);
    float sum = 0.f;
#pragma unroll
    for (int i = 0; i < 3; ++i) { const int j = lane + 64 * i; if (j < nk) { const float p = __expf(sc[i] - mx); ps[j] = p; sum += p; } }
    for (int o = 32; o > 0; o >>= 1) sum += __shfl_xor(sum, o);
    sum += __expf(sink - mx);
    __syncthreads();
    float acc = 0.f;
    for (int j = 0; j < nk; ++j) {
        const float* vp;
        if (prompt) vp = vb + ((size_t)b * SEQ + (t - nk + 1 + j)) * 128 + kvh * 64;
        else vp = j < WINDOW ? cv + ((size_t)b * WINDOW + j) * 128 + kvh * 64 : vb + (size_t)r * 128 + kvh * 64;
        acc = fmaf(ps[j], vp[lane], acc);
    }
    const float z = bf2f(proj[(size_t)r * PLD + OFF_B_Z + hh * 64 + lane]);
    mix[(size_t)r * 1024 + 512 + hh * 64 + lane] = f2bf(acc / sum * siluf(z));
}

__global__ void __launch_bounds__(256) k_ln(const float* __restrict__ xp, const float* __restrict__ xs, const float* __restrict__ mod, const float* __restrict__ pre,
                                            const float* __restrict__ ln_g, const float* __restrict__ ln_b, float* __restrict__ out) {
    const int r = blockIdx.x, tid = threadIdx.x;
    const int mr = r < MP ? r / SEQ : 2 + (r - MP);
    const float* x = r < MP ? xp + (size_t)r * D_MODEL : xs + (size_t)(r - MP) * D_MODEL;
    float* y = r < MP ? out + O_YP + (size_t)r * D_MODEL : out + O_YS + (size_t)(r - MP) * D_MODEL;
    __shared__ float red[256];
    float v[4]; float s = 0.f;
#pragma unroll
    for (int i = 0; i < 4; ++i) { const int c = tid + 256 * i; v[i] = DEEPNORM_ALPHA * x[c] + (1.f + mod[(size_t)mr * 3072 + 2048 + c]) * pre[(size_t)r * D_MODEL + c]; s += v[i]; }
    red[tid] = s; __syncthreads();
    for (int o = 128; o > 0; o >>= 1) { if (tid < o) red[tid] += red[tid + o]; __syncthreads(); }
    const float mean = red[0] * (1.f / 1024.f); __syncthreads();
    float q = 0.f;
#pragma unroll
    for (int i = 0; i < 4; ++i) { v[i] -= mean; q += v[i] * v[i]; }
    red[tid] = q; __syncthreads();
    for (int o = 128; o > 0; o >>= 1) { if (tid < o) red[tid] += red[tid + o]; __syncthreads(); }
    const float rstd = rsqrtf(red[0] * (1.f / 1024.f) + LN_EPS);
#pragma unroll
    for (int i = 0; i < 4; ++i) { const int c = tid + 256 * i; y[c] = v[i] * rstd * ln_g[c] + ln_b[c]; }
}

__global__ void __launch_bounds__(NWAVES * 64, 2) mega(Args args) {
    extern __shared__ __attribute__((aligned(16))) unsigned char lds_raw[];
    Frame F;
    F.lds = (LAS unsigned char*)lds_raw;
    F.MISC = (volatile LAS unsigned*)(F.lds + MISC_OFF);
    F.tid = threadIdx.x; F.lane = F.tid & 63; F.wave = __builtin_amdgcn_readfirstlane(F.tid >> 6);
    F.G = gridDim.x; { const int bx = blockIdx.x; F.vcu = (F.G % 8 == 0) ? (bx % 8) * (F.G / 8) + bx / 8 : bx; }
    F.ws = args.ws; F.out = args.out; F.ctl = (unsigned*)(args.ws + WS_CTL);
    F.x_prompt = args.in[0]; F.x_sample = args.in[1]; F.state_conv = args.in[2]; F.state_delta = args.in[3]; F.cache_k = args.in[4]; F.cache_v = args.in[5];
    F.c_prompt = args.in[6]; F.c_sample = args.in[7]; F.w_ada = args.in[8]; F.b_ada = args.in[9]; F.w_in = args.in[10]; F.conv_w = args.in[11];
    F.a_log = args.in[12]; F.dt_bias = args.in[13]; F.norm_a = args.in[14]; F.sinks = args.in[15]; F.w_out = args.in[16]; F.ln_g = args.in[17]; F.ln_b = args.in[18];
    for (int u = F.tid; u < (LDS_BYTES - LDSCTL_OFF) / 4; u += NWAVES * 64) ((LAS unsigned*)(F.lds + LDSCTL_OFF))[u] = 0u;
    __syncthreads();
    const int lo = args.ph_lo, hi = args.ph_hi;
    XcdBarrier bar; bar.bar = F.ctl + CW_BAR; bar.x = 0; bar.st = nullptr;
    if (hi - lo > 1) bar = xcd_barrier_post(F.ctl + CW_BAR, F.MISC + 8);
#define IN(k) (lo <= (k) && (k) < hi)
#define SEAM(k) do { if (IN(k) && IN((k) + 1)) xcd_barrier(bar); } while (0)
    if (IN(0)) { p0_prologue(F); } SEAM(0);
    if (IN(1)) { p1_h(F); } SEAM(1);
    if (IN(2)) {
        pg8::Gemm g{(const pg8::bf16_t*)(F.ws + WS_H), (const pg8::bf16_t*)(F.ws + WS_WIN), MPAD, PLD, 1024}; pg8::StaticOrder S; S.init(MPAD, PLD, F.G, (int)blockIdx.x);
        pg8::EpiBf16<0> E{(pg8::bf16_t*)(F.ws + WS_PROJ), PLD, nullptr, 0, 0, 1.f};
        pg8::gemm_phase<pg8::EpiBf16<0>, pg8::StaticOrder, true, true>(F.lds, g, S, E);
    } SEAM(2);
    if (IN(3)) { for (int it = F.vcu; it < 1024; it += F.G) e1_item(F, it); } SEAM(3);
    if (IN(4)) { if (blockIdx.x < 64) scan_unit(F, (int)blockIdx.x & 7, (int)blockIdx.x >> 3); } SEAM(4);
    if (IN(5)) { for (int it = F.vcu; it < 1024; it += F.G) o_item(F, it); } SEAM(5);
    if (IN(6)) {
        pg8::Gemm g{(const pg8::bf16_t*)(F.ws + WS_H), (const pg8::bf16_t*)(F.ws + WS_WOUT), MPAD, 1024, 1024}; pg8::StaticOrder S; S.init(MPAD, 1024, F.G, (int)blockIdx.x);
        pg8::EpiF32 E{(float*)(F.ws + WS_X), 1024, nullptr};
        pg8::gemm_phase<pg8::EpiF32, pg8::StaticOrder, true, true>(F.lds, g, S, E);
    }
#undef IN
#undef SEAM
}
extern "C" void kernel_launch(void* const* d_in, const int* in_sizes, int n_in, void* d_out, int out_size, void* d_ws, size_t ws_size, hipStream_t stream) {
    static int grid = 0;
    if (grid == 0) {
        int dev = 0, cus = 0;
        if (n_in != 19 || ws_size < WS_END || hipGetDevice(&dev) != hipSuccess || hipDeviceGetAttribute(&cus, hipDeviceAttributeMultiprocessorCount, dev) != hipSuccess) { fprintf(stderr, "kernel_launch: bad environment (n_in %d ws %zu)\n", n_in, ws_size); grid = -1; return; }
        if (hipFuncSetAttribute((const void*)mega, hipFuncAttributeMaxDynamicSharedMemorySize, LDS_BYTES) != hipSuccess) { fprintf(stderr, "kernel_launch: hipFuncSetAttribute failed\n"); grid = -1; return; }
        grid = cus;
    }
    if (grid < 0) return;
    const float* x_prompt = (const float*)d_in[0]; const float* x_sample = (const float*)d_in[1];
    const float* state_conv = (const float*)d_in[2]; const float* state_delta = (const float*)d_in[3];
    const float* cache_k = (const float*)d_in[4]; const float* cache_v = (const float*)d_in[5];
    const float* conv_w = (const float*)d_in[11]; const float* a_log = (const float*)d_in[12]; const float* dt_bias = (const float*)d_in[13];
    const float* norm_a = (const float*)d_in[14]; const float* sinks = (const float*)d_in[15];
    const float* ln_g = (const float*)d_in[17]; const float* ln_b = (const float*)d_in[18];
    float* out = (float*)d_out; unsigned char* ws = (unsigned char*)d_ws;
    (void)hipMemsetAsync(ws + WS_CTL, 0, CTL_ZERO_BYTES, stream);
    Args a{};
    for (int i = 0; i < 19; ++i) a.in[i] = (const float*)d_in[i];
    a.out = out; a.ws = ws;
    auto run = [&](int lo, int hi) { a.ph_lo = lo; a.ph_hi = hi; hipLaunchKernelGGL(mega, dim3(grid), dim3(NWAVES * 64), LDS_BYTES, stream, a); };
    run(0, 1); run(1, 2); run(2, 3); run(3, 4); run(4, 5); run(5, 6);
    const bf16_t* proj = (const bf16_t*)(ws + WS_PROJ);
    bf16_t* mix = (bf16_t*)(ws + WS_H);
    const float* mod = (const float*)(ws + WS_MOD);
    float* small = (float*)(ws + 31 * MiB);
    float *qa_s = small, *ka_s = small + 128 * 512, *va_s = small + 2 * 128 * 512, *beta_s = small + 3 * 128 * 512, *g_s = beta_s + 512;
    float *qb = out, *kb = out + (size_t)MT * 512, *vb = kb + (size_t)MT * 128;
    float* pre = (float*)(ws + WS_X);
    k_convA<<<dim3(DEC_BATCH, 4), 128, 0, stream>>>(proj, state_conv, conv_w, a_log, dt_bias, qa_s, ka_s, va_s, beta_s, g_s, MP);
    k_conv_state<<<(DEC_BATCH * 3 * A_QKV + 255) / 256, 256, 0, stream>>>(proj, state_conv, out);
    k_delta_rec<<<DEC_BATCH * 4, 128, 0, stream>>>(qa_s, ka_s, va_s, beta_s, g_s, state_delta, out + O_DELTAS, qa_s, 0, 1);
    k_rms_gate<<<dim3(DEC_BATCH, 4), 128, 0, stream>>>(qa_s, proj, norm_a, mix, MP);
    k_rope<<<MT, 128, 0, stream>>>(proj, qb, kb, vb);
    k_cache_out<<<(DEC_BATCH * WINDOW * 128 + 255) / 256, 256, 0, stream>>>(kb, vb, cache_k, cache_v, out);
    k_swa<<<dim3(MT, 8), 64, 0, stream>>>(qb, kb, vb, cache_k, cache_v, sinks, proj, mix);
    run(6, 7);
    k_ln<<<MT, 256, 0, stream>>>(x_prompt, x_sample, mod, pre, ln_g, ln_b, out);
}
```

```cpp
#include <hip/hip_runtime.h>
#include <cstdio>
#include <cstdint>
#include <cstddef>

constexpr int D_MODEL = 1024, BATCH = 2, SEQ = 8192, DEC_BATCH = 128, PAST_LEN = 8192;
constexpr int A_HEADS = 4, A_DK = 128, A_DV = 128, A_WIDTH = 512, A_QKV = 1536, CONV_W = 4;
constexpr int B_HEADS = 8, B_KV_HEADS = 2, B_HD = 64, B_GROUP = 4, B_WIDTH = 512, B_KV_WIDTH = 128, WINDOW = 128;
constexpr int OFF_A_QKV = 0, OFF_A_Z = 1536, OFF_A_BETA = 2048, OFF_A_DECAY = 2052, OFF_B_Q = 2056, OFF_B_K = 2568, OFF_B_V = 2696, OFF_B_Z = 2824, PROJ_COLS = 3336;
constexpr int MP = BATCH * SEQ;
constexpr int MT = MP + DEC_BATCH;
constexpr int MPAD = 16640;
constexpr int PLD = 3584;
constexpr float LN_EPS = 1e-5f, RMS_EPS = 1e-6f, L2_EPS = 1e-6f;
constexpr float DEEPNORM_ALPHA = 1.189207115002721f;

constexpr size_t O_YP = 0;
constexpr size_t O_YS = O_YP + (size_t)MP * D_MODEL;
constexpr size_t O_CONVP = O_YS + (size_t)DEC_BATCH * D_MODEL;
constexpr size_t O_DELTAP = O_CONVP + (size_t)BATCH * 3 * A_QKV;
constexpr size_t O_KP = O_DELTAP + (size_t)BATCH * A_HEADS * A_DK * A_DV;
constexpr size_t O_VP = O_KP + (size_t)BATCH * WINDOW * B_KV_WIDTH;
constexpr size_t O_CONVS = O_VP + (size_t)BATCH * WINDOW * B_KV_WIDTH;
constexpr size_t O_DELTAS = O_CONVS + (size_t)DEC_BATCH * 3 * A_QKV;
constexpr size_t O_KS = O_DELTAS + (size_t)DEC_BATCH * A_HEADS * A_DK * A_DV;
constexpr size_t O_VS = O_KS + (size_t)DEC_BATCH * WINDOW * B_KV_WIDTH;
constexpr size_t O_END = O_VS + (size_t)DEC_BATCH * WINDOW * B_KV_WIDTH;

constexpr size_t MiB = 1u << 20;
constexpr size_t WS_CTL = 0, CTL_ZERO_BYTES = 1 * MiB;
constexpr size_t WS_WIN = 2 * MiB;
constexpr size_t WS_WOUT = 10 * MiB;
constexpr size_t WS_MOD = 12 * MiB;
constexpr size_t WS_SLAB = 14 * MiB;
constexpr size_t WS_ROPE = 28 * MiB;
constexpr size_t WS_H = 32 * MiB;
constexpr size_t WS_PROJ = 66 * MiB;
constexpr size_t WS_X = 180 * MiB;
constexpr size_t WS_END = 256 * MiB;
constexpr int CW_BAR = 4096;

typedef unsigned short bf16_t;
typedef float f32x4 __attribute__((ext_vector_type(4)));
typedef unsigned u32x4 __attribute__((ext_vector_type(4)));
typedef unsigned u32x2 __attribute__((ext_vector_type(2)));
typedef short bf16x8 __attribute__((ext_vector_type(8)));
__device__ __forceinline__ float bf2f(bf16_t v) { return __uint_as_float(((unsigned)v) << 16); }
__device__ __forceinline__ bf16_t f2bf(float f) { unsigned u = __float_as_uint(f); return (bf16_t)((u + 0x7fffu + ((u >> 16) & 1u)) >> 16); }
__device__ __forceinline__ unsigned pk2(float lo, float hi) { return (unsigned)f2bf(lo) | ((unsigned)f2bf(hi) << 16); }
__device__ __forceinline__ void stc(float* p, float v) { *p = v; }
__device__ __forceinline__ void stc(bf16_t* p, float v) { *p = f2bf(v); }
__device__ __forceinline__ float siluf(float x) { return x / (1.f + __expf(-x)); }
__device__ __forceinline__ float sigmoidf_(float x) { return 1.f / (1.f + __expf(-x)); }
__device__ __forceinline__ float softplusf_(float x) { return x > 20.f ? x : log1pf(__expf(x)); }
__device__ __forceinline__ void rope_cs(int pos, int i, float& c, float& s) {
    const float inv = 1.0f / powf(10000.0f, (float)i / 32.0f);
    const float ang = (float)pos * inv;
    const double a = (double)ang;
    const double k = rint(a * 0.15915494309189535);
    const double rr = a - k * 6.283185307179586;
    c = (float)cos(rr); s = (float)sin(rr);
}
namespace pg8 {
#define PG8_LAS __attribute__((address_space(3)))
typedef unsigned short bf16_t;
typedef short bf16x8 __attribute__((ext_vector_type(8)));
typedef float f32x4 __attribute__((ext_vector_type(4)));
typedef unsigned u32x4 __attribute__((ext_vector_type(4)));
constexpr int BM = 256, BK = 64, HALF = 128, HTB = HALF * BK * 2  , STAGE_BYTES = 8 * HTB, NXCD = 8, WGM = 8;

__host__ __device__ __forceinline__ int lds_byte(int r, int c) { const int st = (r >> 4) * 2 + (c >> 5), rr = r & 15, cc = c & 31, ob = rr * 64 + cc * 2; return st * 1024 + (ob ^ (((ob >> 9) & 1) << 5)); }
__host__ __device__ __forceinline__ void stage_rc(int b, int& R, int& C) { const int st = b / 1024, sb = b % 1024, swz = sb ^ (((sb >> 9) & 1) << 5); R = (st >> 1) * 16 + swz / 64; C = (st & 1) * 32 + (swz % 64) / 2; }
__host__ __device__ __forceinline__ int perm32(int rho) { const int n = rho >> 4, i = rho & 15; return 8 * (i >> 2) + 4 * n + (i & 3); }

struct Unit { int pm, pn; };
struct Gemm { const bf16_t* A; const bf16_t* Bt; int M, N, K; };

struct StaticOrder {
    int nM, nN, nwg, G, c;
    __host__ __device__ void init(int M, int N, int G_, int c_) { nM = M / BM; nN = N / BM; nwg = nM * nN; G = G_; c = c_; }
    __host__ __device__ bool next(int i, Unit& u) const {
        const long L = (long)i * G + c; if (L >= nwg) return false;
        int wgid = (int)L; { const int q = nwg / NXCD, r = nwg % NXCD, xcd = wgid % NXCD, off = wgid / NXCD; wgid = (xcd < r ? xcd * (q + 1) : r * (q + 1) + (xcd - r) * q) + off; }
        const int nig = WGM * nN, gid = wgid / nig, fm = gid * WGM, gsz = (nM - fm) < WGM ? (nM - fm) : WGM;
        u.pm = fm + ((wgid % nig) % gsz); u.pn = (wgid % nig) / gsz; return true;
    }
    __device__ __forceinline__ void a_ready(const Unit&) const {}
    __device__ __forceinline__ void done(const Unit&) const {}
};

__device__ __forceinline__ unsigned cvt_pk_bf16(float lo, float hi) { unsigned r; asm volatile("v_cvt_pk_bf16_f32 %0, %1, %2" : "=v"(r) : "v"(lo), "v"(hi)); return r; }
typedef float f32x2 __attribute__((ext_vector_type(2)));
__device__ __forceinline__ f32x2 gelu_pk(f32x2 v) {
    const f32x2 av = __builtin_elementwise_abs(v), d = av * 0.2316418882f + 1.0f;
    f32x2 t; t.x = __builtin_amdgcn_rcpf(d.x); t.y = __builtin_amdgcn_rcpf(d.y);
    f32x2 q = t * 0.5307027145f + (-0.7265760135f); q = q * t + 0.7107068705f; q = q * t + (-0.142248368f); q = q * t + 0.127414796f; q = q * t;
    const f32x2 s = (v * v) * (-0.72134752044f);
    f32x2 e; e.x = __builtin_amdgcn_exp2f(s.x); e.y = __builtin_amdgcn_exp2f(s.y);
    const f32x2 m = v * (q * e), r = v - m;
    f32x2 o; o.x = v.x < 0.f ? m.x : r.x; o.y = v.y < 0.f ? m.y : r.y; return o;
}

struct EpiF32 {
    static constexpr bool PERM = false, AFTER_DRAIN = false;
    float* C; int ldc; const float* bias;
    __device__ __forceinline__ void operator()(const f32x4 (&acc)[2][2][4][2], const Unit& u, int wr, int wc, int fr, int fq) const {
        const int row0 = u.pm * BM + wr * 64 + fr, col0 = u.pn * BM + wc * 32 + 4 * fq;
        f32x4 bv[2][2];
#pragma unroll
        for (int bj = 0; bj < 2; ++bj)
#pragma unroll
            for (int n = 0; n < 2; ++n) bv[bj][n] = bias ? *(const f32x4*)(bias + col0 + bj * HALF + n * 16) : (f32x4){0.f, 0.f, 0.f, 0.f};
#pragma unroll
        for (int ai = 0; ai < 2; ++ai)
#pragma unroll
            for (int m = 0; m < 4; ++m) { float* rowp = C + (size_t)(row0 + ai * HALF + m * 16) * ldc + col0;
#pragma unroll
                for (int bj = 0; bj < 2; ++bj)
#pragma unroll
                    for (int n = 0; n < 2; ++n) *(f32x4*)(rowp + bj * HALF + n * 16) = acc[ai][bj][m][n] + bv[bj][n]; }
    }
};
template <int ACT  > struct EpiBf16 {
    static constexpr bool PERM = true, AFTER_DRAIN = false; static_assert(ACT == 0 || ACT == 1, "EpiBf16: ACT is 0 (none) or 1 (gelu_pk)");
    bf16_t* O; int ldc; const float* bias; int split_cols; size_t split_stride; float scale0;
    __device__ __forceinline__ void operator()(const f32x4 (&acc)[2][2][4][2], const Unit& u, int wr, int wc, int fr, int fq) const {
        const int row0 = u.pm * BM + wr * 64 + fr; int colt = u.pn * BM; bf16_t* base = O;
        float sc = 1.f; if (split_cols) { const int t = colt / split_cols; base += (size_t)t * split_stride; colt -= t * split_cols; if (t == 0) sc = scale0; }
        const int col0 = colt + wc * 32 + 8 * fq, bcol0 = u.pn * BM + wc * 32 + 8 * fq;
        f32x4 bv[2][2];
#pragma unroll
        for (int bj = 0; bj < 2; ++bj)
#pragma unroll
            for (int n = 0; n < 2; ++n) bv[bj][n] = bias ? *(const f32x4*)(bias + bcol0 + bj * HALF + 4 * n) : (f32x4){0.f, 0.f, 0.f, 0.f};
#pragma unroll
        for (int ai = 0; ai < 2; ++ai)
#pragma unroll
            for (int m = 0; m < 4; ++m) { bf16_t* rowp = base + (size_t)(row0 + ai * HALF + m * 16) * ldc + col0;
#pragma unroll
                for (int bj = 0; bj < 2; ++bj) { f32x4 v0 = acc[ai][bj][m][0] + bv[bj][0], v1 = acc[ai][bj][m][1] + bv[bj][1];
                    if (ACT == 1) { f32x2 a = gelu_pk((f32x2){v0[0], v0[1]}), b = gelu_pk((f32x2){v0[2], v0[3]}), c = gelu_pk((f32x2){v1[0], v1[1]}), d = gelu_pk((f32x2){v1[2], v1[3]});
                        v0 = (f32x4){a.x, a.y, b.x, b.y}; v1 = (f32x4){c.x, c.y, d.x, d.y}; }
                    v0 = v0 * sc; v1 = v1 * sc; u32x4 w; w.x = cvt_pk_bf16(v0[0], v0[1]); w.y = cvt_pk_bf16(v0[2], v0[3]); w.z = cvt_pk_bf16(v1[0], v1[1]); w.w = cvt_pk_bf16(v1[2], v1[3]);
                    *(u32x4*)(rowp + bj * HALF) = w; } }
    }
};

struct PanelStats {
    unsigned* xbuf;
    unsigned* cnt;
    unsigned* tmo;
    int ntn; float eps;
    unsigned code;
    __device__ __forceinline__ bool run(const f32x4 (&v)[2][2][4][2], const Unit& u, int wr, int wc, int fr, int fq, PG8_LAS unsigned char* lds, int wid, int lane) const {
        typedef float f32x2v __attribute__((ext_vector_type(2)));
        PG8_LAS f32x2v* P = (PG8_LAS f32x2v*)lds;
        PG8_LAS f32x2v* S = (PG8_LAS f32x2v*)(lds + 8192);
        PG8_LAS unsigned* flag = (PG8_LAS unsigned*)(lds + 8192 + 2048);
#pragma unroll
        for (int ai = 0; ai < 2; ++ai)
#pragma unroll
            for (int m = 0; m < 4; ++m) {
                float s = 0.f;
#pragma unroll
                for (int bj = 0; bj < 2; ++bj)
#pragma unroll
                    for (int n = 0; n < 2; ++n) { const f32x4 x = v[ai][bj][m][n]; s += (x[0] + x[1]) + (x[2] + x[3]); }
                s += __shfl_xor(s, 16); s += __shfl_xor(s, 32);
                const float mw = s * (1.0f / 64.0f); float q = 0.f;
#pragma unroll
                for (int bj = 0; bj < 2; ++bj)
#pragma unroll
                    for (int n = 0; n < 2; ++n) { const f32x4 d = v[ai][bj][m][n] - mw; q += (d[0] * d[0] + d[1] * d[1]) + (d[2] * d[2] + d[3] * d[3]); }
                q += __shfl_xor(q, 16); q += __shfl_xor(q, 32);
                if (fq == 0) P[(ai * HALF + wr * 64 + m * 16 + fr) * 4 + wc] = (f32x2v){mw, q};
            }
        asm volatile("s_waitcnt lgkmcnt(0)" ::: "memory"); __builtin_amdgcn_s_barrier(); asm volatile("" ::: "memory");
#if defined(BROKEN_EXCHANGE_NO_WAIT)
#warning BROKEN CONTROL BUILD: the row-statistics exchange does not wait; results are wrong by design
        if (blockIdx.x >= 64) { const long long t0_ = clock64(); while (clock64() - t0_ < 60000) __builtin_amdgcn_s_sleep(8); }
#endif
        const int row = wid * 32 + (lane & 31);
        if (lane < 32) {
            const f32x2v a = P[row * 4 + 0], b = P[row * 4 + 1], c = P[row * 4 + 2], d = P[row * 4 + 3];
            const float mt = (a.x + b.x + c.x + d.x) * 0.25f;
            const float da = a.x - mt, db = b.x - mt, dc = c.x - mt, dd = d.x - mt;
            const float m2 = (a.y + b.y) + (c.y + d.y) + 64.0f * ((da * da + db * db) + (dc * dc + dd * dd));
            unsigned long long* slot = (unsigned long long*)xbuf + ((size_t)(u.pm * BM + row) * 4 + u.pn);
            __hip_atomic_store(slot, ((unsigned long long)__float_as_uint(m2) << 32) | __float_as_uint(mt), __ATOMIC_RELAXED, __HIP_MEMORY_SCOPE_AGENT);
        }
        asm volatile("s_waitcnt vmcnt(0)" ::: "memory");
        if (lane == 0) __hip_atomic_fetch_add(cnt + 64 * u.pm, 1u, __ATOMIC_RELAXED, __HIP_MEMORY_SCOPE_AGENT);
        if (wid == 0) {
            bool dead = false; const unsigned long long t0 = __builtin_amdgcn_s_memrealtime(); const unsigned want = 8u * (unsigned)ntn;
            for (;;) {
#if defined(BROKEN_EXCHANGE_NO_WAIT)
                break;
#endif
                if ((unsigned)__builtin_amdgcn_readfirstlane(__hip_atomic_load(cnt + 64 * u.pm, __ATOMIC_RELAXED, __HIP_MEMORY_SCOPE_AGENT)) >= want) break;
                if (__builtin_amdgcn_s_memrealtime() - t0 > 2000000ull) {
                    if (lane == 0) { unsigned expect = 0u; __hip_atomic_compare_exchange_strong(tmo + 1, &expect, code | (unsigned)(u.pm & 0xff), __ATOMIC_RELAXED, __ATOMIC_RELAXED, __HIP_MEMORY_SCOPE_AGENT);
                                     __hip_atomic_store(tmo, 1u, __ATOMIC_RELAXED, __HIP_MEMORY_SCOPE_AGENT); }
                    dead = true; break; }
                __builtin_amdgcn_s_sleep(2);
            }
            __builtin_amdgcn_fence(__ATOMIC_ACQUIRE, "agent");
            if (lane == 0) flag[0] = dead ? 1u : 0u;
        }
        asm volatile("s_waitcnt vmcnt(0) lgkmcnt(0)" ::: "memory"); __builtin_amdgcn_s_barrier(); asm volatile("" ::: "memory");
        const bool bad = flag[0] != 0u;
        if (lane < 32) {
            const unsigned long long* slot = (const unsigned long long*)xbuf + (size_t)(u.pm * BM + row) * 4; float mt[4], m2[4]; float ms = 0.f;
#pragma unroll
            for (int t = 0; t < 4; ++t) { if (t < ntn) { const unsigned long long w = __hip_atomic_load(slot + t, __ATOMIC_RELAXED, __HIP_MEMORY_SCOPE_AGENT); mt[t] = __uint_as_float((unsigned)w); m2[t] = __uint_as_float((unsigned)(w >> 32)); } else { mt[t] = 0.f; m2[t] = 0.f; } ms += mt[t]; }
            const float mean = ms / (float)ntn; float q = 0.f;
#pragma unroll
            for (int t = 0; t < 4; ++t) if (t < ntn) { const float dm = mt[t] - mean; q += m2[t] + 256.0f * dm * dm; }
            S[row] = (f32x2v){mean, 1.0f / sqrtf(q / (256.0f * (float)ntn) + eps)};
        }
        asm volatile("s_waitcnt lgkmcnt(0)" ::: "memory"); __builtin_amdgcn_s_barrier(); asm volatile("" ::: "memory");
        return bad;
    }
};
struct EpiLnRes {
    static constexpr bool PERM = false, AFTER_DRAIN = true;
    const float* base; float* out; int ldc; const float* bias; PanelStats st; unsigned poison;
    __device__ __forceinline__ void fused(f32x4 (&acc)[2][2][4][2], const Unit& u, int wr, int wc, int fr, int fq, PG8_LAS unsigned char* lds, int wid, int lane) const {
        typedef float f32x2v __attribute__((ext_vector_type(2)));
        const PG8_LAS f32x2v* S = (const PG8_LAS f32x2v*)(lds + 8192);
        const int col0 = u.pn * BM + wc * 32 + 4 * fq;
#pragma unroll
        for (int bj = 0; bj < 2; ++bj)
#pragma unroll
            for (int n = 0; n < 2; ++n) { const f32x4 bv = bias ? *(const f32x4*)(bias + col0 + bj * HALF + n * 16) : (f32x4){0.f, 0.f, 0.f, 0.f};
#pragma unroll
                for (int ai = 0; ai < 2; ++ai)
#pragma unroll
                    for (int m = 0; m < 4; ++m) acc[ai][bj][m][n] += bv; }
        f32x4 pre[4][2][2];
#pragma unroll
        for (int m = 0; m < 4; ++m) { const size_t off = (size_t)(u.pm * BM + wr * 64 + m * 16 + fr) * ldc + col0;
#pragma unroll
            for (int bj = 0; bj < 2; ++bj)
#pragma unroll
                for (int n = 0; n < 2; ++n) pre[m][bj][n] = *(const f32x4*)(base + off + bj * HALF + n * 16); }
        const bool bad = st.run(acc, u, wr, wc, fr, fq, lds, wid, lane) || poison != 0u;
        const float qnan = __builtin_nanf("");
#pragma unroll
        for (int ai = 0; ai < 2; ++ai)
#pragma unroll
            for (int m = 0; m < 4; ++m) { const int r = ai * HALF + wr * 64 + m * 16 + fr; const f32x2v sr = S[r]; const size_t off = (size_t)(u.pm * BM + r) * ldc + col0;
#pragma unroll
                for (int bj = 0; bj < 2; ++bj)
#pragma unroll
                    for (int n = 0; n < 2; ++n) { const f32x4 bs = ai == 0 ? pre[m][bj][n] : *(const f32x4*)(base + off + bj * HALF + n * 16); f32x4 o = bs + (acc[ai][bj][m][n] - sr.x) * sr.y;
                        if (bad) o = (f32x4){qnan, qnan, qnan, qnan}; *(f32x4*)(out + off + bj * HALF + n * 16) = o; }
                if (m & 1) asm volatile("" ::: "memory"); }
    }
};
struct EpiLnResLn {
    static constexpr bool PERM = false, AFTER_DRAIN = true;
    const float* base; float* out; bf16_t* xn; int ldc; const float* bias; PanelStats st1, st2; unsigned poison;
    __device__ __forceinline__ void fused(f32x4 (&acc)[2][2][4][2], const Unit& u, int wr, int wc, int fr, int fq, PG8_LAS unsigned char* lds, int wid, int lane) const {
        typedef float f32x2v __attribute__((ext_vector_type(2))); typedef unsigned u32x2v __attribute__((ext_vector_type(2)));
        const PG8_LAS f32x2v* S = (const PG8_LAS f32x2v*)(lds + 8192);
        const int col0 = u.pn * BM + wc * 32 + 4 * fq;
#pragma unroll
        for (int bj = 0; bj < 2; ++bj)
#pragma unroll
            for (int n = 0; n < 2; ++n) { const f32x4 bv = bias ? *(const f32x4*)(bias + col0 + bj * HALF + n * 16) : (f32x4){0.f, 0.f, 0.f, 0.f};
#pragma unroll
                for (int ai = 0; ai < 2; ++ai)
#pragma unroll
                    for (int m = 0; m < 4; ++m) acc[ai][bj][m][n] += bv; }
        bool bad = st1.run(acc, u, wr, wc, fr, fq, lds, wid, lane) || poison != 0u;
        const float qnan = __builtin_nanf("");
#pragma unroll
        for (int ai = 0; ai < 2; ++ai)
#pragma unroll
            for (int m = 0; m < 4; ++m) { const int r = ai * HALF + wr * 64 + m * 16 + fr; const f32x2v sr = S[r]; const size_t off = (size_t)(u.pm * BM + r) * ldc + col0;
#pragma unroll
                for (int bj = 0; bj < 2; ++bj)
#pragma unroll
                    for (int n = 0; n < 2; ++n) { const f32x4 bs = *(const f32x4*)(base + off + bj * HALF + n * 16); acc[ai][bj][m][n] = bs + (acc[ai][bj][m][n] - sr.x) * sr.y; }
                asm volatile("" : "+v"(acc[ai][0][m][0]), "+v"(acc[ai][0][m][1]), "+v"(acc[ai][1][m][0]), "+v"(acc[ai][1][m][1]));
                if (m & 1) asm volatile("" ::: "memory"); }
        const bool bad1 = bad;
        bad = st2.run(acc, u, wr, wc, fr, fq, lds, wid, lane) || bad;
#pragma unroll
        for (int ai = 0; ai < 2; ++ai)
#pragma unroll
            for (int m = 0; m < 4; ++m) { const int r = ai * HALF + wr * 64 + m * 16 + fr; const f32x2v sr = S[r]; const size_t off = (size_t)(u.pm * BM + r) * ldc + col0;
#pragma unroll
                for (int bj = 0; bj < 2; ++bj)
#pragma unroll
                    for (int n = 0; n < 2; ++n) { const f32x4 x1 = acc[ai][bj][m][n]; *(f32x4*)(out + off + bj * HALF + n * 16) = bad1 ? (f32x4){qnan, qnan, qnan, qnan} : x1;
                        const f32x4 o = (x1 - sr.x) * sr.y; u32x2v w; w.x = cvt_pk_bf16(o[0], o[1]); w.y = cvt_pk_bf16(o[2], o[3]);
                        if (bad) { w.x = 0x7fc07fc0u; w.y = 0x7fc07fc0u; } *(u32x2v*)(xn + off + bj * HALF + n * 16) = w; }
                asm volatile("" ::: "memory"); }
    }
};

template <class Epi, class Sched, bool ALIGN_EPI = false, bool SP2 = false>
__device__ __forceinline__ void gemm_phase(PG8_LAS unsigned char* lds, const Gemm g, const Sched& S, const Epi& E) {
    const int tid = threadIdx.x, wid = __builtin_amdgcn_readfirstlane(tid >> 6), lane = tid & 63, wr = wid >> 2, wc = wid & 3, fr = lane & 15, fq = lane >> 4;
    const int K = g.K, nt = K / BK;
    unsigned voffA[2], voffB[2];
#pragma unroll
    for (int i = 0; i < 2; ++i) { int R, C; stage_rc(tid * 16 + i * 8192, R, C); const int Rb = Epi::PERM ? ((R & ~31) + perm32(R & 31)) : R;
        voffA[i] = (unsigned)(R * K + C) * 2u; voffB[i] = (unsigned)(Rb * K + C) * 2u; }
    const size_t kstep = (size_t)(BK * 2);
    const size_t hstep = (size_t)HALF * K * 2;
    const size_t tstep = 2 * hstep;
    const unsigned ldsw = (unsigned)wid * 1024u;
    const int aoff = lds_byte(wr * 64 + fr, fq * 8), boff = lds_byte(wc * 32 + fr, fq * 8);
#define PG8_SA(b, h) (((b) * 2 + (h)) * HTB)
#define PG8_SB(b, h) ((4 + (b) * 2 + (h)) * HTB)
#define PG8_STAGE(bufoff, gbase, voff) do { _Pragma("unroll") for (int _i = 0; _i < 2; ++_i) \
        __builtin_amdgcn_global_load_lds((const unsigned*)((const char*)(gbase) + (voff)[_i]), (PG8_LAS unsigned*)(lds + (bufoff) + ldsw + _i * 8192), 16, 0, 0); } while (0)
#define PG8_LDA(dst, b, h) do { _Pragma("unroll") for (int m = 0; m < 4; ++m) _Pragma("unroll") for (int k = 0; k < 2; ++k) dst[m][k] = *(const PG8_LAS bf16x8*)(lds + PG8_SA(b, h) + aoff + m * 2048 + k * 1024); } while (0)
#define PG8_LDB(dst, b, h) do { _Pragma("unroll") for (int n = 0; n < 2; ++n) _Pragma("unroll") for (int k = 0; k < 2; ++k) dst[n][k] = *(const PG8_LAS bf16x8*)(lds + PG8_SB(b, h) + boff + n * 2048 + k * 1024); } while (0)
#define PG8_MMA(ai, bj, At, Bt) do { __builtin_amdgcn_s_setprio(1); _Pragma("unroll") for (int m = 0; m < 4; ++m) _Pragma("unroll") for (int n = 0; n < 2; ++n) _Pragma("unroll") for (int k = 0; k < 2; ++k) \
        acc[ai][bj][m][n] = __builtin_amdgcn_mfma_f32_16x16x32_bf16(Bt[n][k], At[m][k], acc[ai][bj][m][n], 0, 0, 0); __builtin_amdgcn_s_setprio(0); } while (0)
#define PG8_WAIT_V(n) asm volatile("s_waitcnt vmcnt(" #n ")" ::: "memory")
#define PG8_WAIT_L(n) asm volatile("s_waitcnt lgkmcnt(" #n ")" ::: "memory")
#define PG8_BAR __builtin_amdgcn_s_barrier()
#define PG8_SCHED __builtin_amdgcn_sched_barrier(0)
    Unit cur, nxt; int ui = 0;
    if (!S.next(0, cur)) return;
    f32x4 acc[2][2][4][2];
#pragma unroll
    for (int a = 0; a < 2; ++a)
#pragma unroll
        for (int b = 0; b < 2; ++b)
#pragma unroll
            for (int m = 0; m < 4; ++m)
#pragma unroll
                for (int n = 0; n < 2; ++n) acc[a][b][m][n] = (f32x4){0.f, 0.f, 0.f, 0.f};
    bf16x8 At[4][2], B0[2][2], B1[2][2];
    const char* cA = (const char*)g.A + (size_t)cur.pm * tstep; const char* cB = (const char*)g.Bt + (size_t)cur.pn * tstep;
    S.a_ready(cur);
    if constexpr (SP2) {
        PG8_STAGE(PG8_SB(0, 0), cB, voffB); PG8_STAGE(PG8_SB(0, 1), cB + hstep, voffB); PG8_STAGE(PG8_SA(0, 0), cA, voffA); PG8_STAGE(PG8_SA(0, 1), cA + hstep, voffA);
        if (wr == 1) PG8_BAR;
        PG8_WAIT_V(2); PG8_BAR;
        PG8_STAGE(PG8_SB(1, 0), cB + kstep, voffB); PG8_STAGE(PG8_SA(1, 0), cA + kstep, voffA); PG8_STAGE(PG8_SB(1, 1), cB + hstep + kstep, voffB);
        PG8_WAIT_V(6); PG8_BAR;
    } else {
        PG8_STAGE(PG8_SB(0, 0), cB, voffB); PG8_STAGE(PG8_SA(0, 0), cA, voffA); PG8_STAGE(PG8_SB(0, 1), cB + hstep, voffB); PG8_STAGE(PG8_SA(0, 1), cA + hstep, voffA);
        if (wr == 1) PG8_BAR;
        PG8_WAIT_V(4); PG8_BAR;
        PG8_STAGE(PG8_SB(1, 0), cB + kstep, voffB); PG8_STAGE(PG8_SA(1, 0), cA + kstep, voffA); PG8_STAGE(PG8_SB(1, 1), cB + hstep + kstep, voffB);
        PG8_WAIT_V(6); PG8_BAR;
    }
    for (;;) {
        const bool has_next = S.next(ui + 1, nxt);
        const char* nA = has_next ? (const char*)g.A + (size_t)nxt.pm * tstep : cA; const char* nB = has_next ? (const char*)g.Bt + (size_t)nxt.pn * tstep : cB;
        for (int t = 0; t < nt; t += 2) {
            const bool last = (t == nt - 2);
            const char* a1 = cA + (size_t)(t + 1) * kstep;
            const char* a2 = last ? nA : cA + (size_t)(t + 2) * kstep; const char* b2 = last ? nB : cB + (size_t)(t + 2) * kstep;
            const char* a3 = a2 + kstep; const char* b3 = b2 + kstep;
            if (last && has_next) S.a_ready(nxt);
            if constexpr (SP2) {
            PG8_LDB(B0, 0, 0); PG8_LDB(B1, 0, 1); PG8_SCHED; PG8_LDA(At, 0, 0); PG8_STAGE(PG8_SA(1, 1), a1 + hstep, voffA);
            PG8_WAIT_V(8); PG8_WAIT_L(0); PG8_BAR; PG8_MMA(0, 0, At, B0); PG8_MMA(0, 1, At, B1); PG8_BAR; PG8_SCHED;
            PG8_LDA(At, 0, 1); PG8_STAGE(PG8_SB(0, 0), b2, voffB); PG8_STAGE(PG8_SB(0, 1), b2 + hstep, voffB); PG8_STAGE(PG8_SA(0, 0), a2, voffA);
            PG8_WAIT_V(8); PG8_WAIT_L(0); PG8_BAR; PG8_MMA(1, 0, At, B0); PG8_MMA(1, 1, At, B1); PG8_BAR; PG8_SCHED;
            PG8_LDB(B0, 1, 0); PG8_LDB(B1, 1, 1); PG8_SCHED; PG8_LDA(At, 1, 0); PG8_STAGE(PG8_SA(0, 1), a2 + hstep, voffA);
            PG8_WAIT_V(8); PG8_WAIT_L(0); PG8_BAR; PG8_MMA(0, 0, At, B0); PG8_MMA(0, 1, At, B1); PG8_BAR; PG8_SCHED;
            PG8_LDA(At, 1, 1); PG8_STAGE(PG8_SB(1, 0), b3, voffB); PG8_STAGE(PG8_SB(1, 1), b3 + hstep, voffB); PG8_STAGE(PG8_SA(1, 0), a3, voffA);
            PG8_WAIT_V(8); PG8_WAIT_L(0); PG8_BAR; PG8_MMA(1, 0, At, B0); PG8_MMA(1, 1, At, B1); PG8_BAR; PG8_SCHED;
            } else {
            PG8_LDB(B0, 0, 0); PG8_SCHED; PG8_LDA(At, 0, 0); PG8_STAGE(PG8_SA(1, 1), a1 + hstep, voffA);
            PG8_WAIT_L(8); PG8_BAR; PG8_WAIT_L(0); PG8_MMA(0, 0, At, B0); PG8_BAR; PG8_SCHED;
            PG8_LDB(B1, 0, 1); PG8_STAGE(PG8_SB(0, 0), b2, voffB);
            PG8_BAR; PG8_WAIT_L(0); PG8_MMA(0, 1, At, B1); PG8_BAR;
            PG8_LDA(At, 0, 1); PG8_STAGE(PG8_SA(0, 0), a2, voffA);
            PG8_BAR; PG8_WAIT_L(0); PG8_MMA(1, 0, At, B0); PG8_BAR; PG8_SCHED;
            PG8_STAGE(PG8_SB(0, 1), b2 + hstep, voffB);
            PG8_WAIT_V(6); PG8_BAR; PG8_MMA(1, 1, At, B1); PG8_BAR;
            PG8_LDB(B0, 1, 0); PG8_SCHED; PG8_LDA(At, 1, 0); PG8_STAGE(PG8_SA(0, 1), a2 + hstep, voffA);
            PG8_WAIT_L(8); PG8_BAR; PG8_WAIT_L(0); PG8_MMA(0, 0, At, B0); PG8_BAR; PG8_SCHED;
            PG8_LDB(B1, 1, 1); PG8_STAGE(PG8_SB(1, 0), b3, voffB);
            PG8_BAR; PG8_WAIT_L(0); PG8_MMA(0, 1, At, B1); PG8_BAR;
            PG8_LDA(At, 1, 1); PG8_STAGE(PG8_SA(1, 0), a3, voffA);
            PG8_BAR; PG8_WAIT_L(0); PG8_MMA(1, 0, At, B0); PG8_BAR; PG8_SCHED;
            PG8_STAGE(PG8_SB(1, 1), b3 + hstep, voffB);
            PG8_WAIT_V(6); PG8_BAR; PG8_MMA(1, 1, At, B1); PG8_BAR;
            }
        }
        if constexpr (ALIGN_EPI) { if (wr == 0) PG8_BAR; }
        if constexpr (!Epi::AFTER_DRAIN) { E(acc, cur, wr, wc, fr, fq); S.done(cur); }
        if (!has_next) break;
#pragma unroll
        for (int a = 0; a < 2; ++a)
#pragma unroll
            for (int b = 0; b < 2; ++b)
#pragma unroll
                for (int m = 0; m < 4; ++m)
#pragma unroll
                    for (int n = 0; n < 2; ++n) acc[a][b][m][n] = (f32x4){0.f, 0.f, 0.f, 0.f};
        cur = nxt; cA = nA; cB = nB; ++ui;
        if constexpr (ALIGN_EPI) { if (wr == 1) PG8_BAR; }
    }
    PG8_WAIT_V(0);
    if constexpr (!ALIGN_EPI) { if (wr == 0) PG8_BAR; }
    PG8_BAR;
    if constexpr (Epi::AFTER_DRAIN) { E.fused(acc, cur, wr, wc, fr, fq, lds, wid, lane); S.done(cur); }
#undef PG8_SA
#undef PG8_SB
#undef PG8_STAGE
#undef PG8_LDA
#undef PG8_LDB
#undef PG8_MMA
#undef PG8_WAIT_V
#undef PG8_WAIT_L
#undef PG8_BAR
#undef PG8_SCHED
}
}
#define GAS __attribute__((address_space(1)))
#define LAS __attribute__((address_space(3)))
typedef GAS unsigned gu32;
#define LDS_WAIT() asm volatile("s_waitcnt lgkmcnt(0)" ::: "memory")
#define VM_WAIT() asm volatile("s_waitcnt vmcnt(0)" ::: "memory")
#define XB_TMO      128
#define XB_XCNT(j)  (256  + 64 * (j))
#define XB_XSUB(j)  (1280 + 64 * (j))
#define XB_XGEN(j)  (2304 + 64 * (j))
#define XB_TOP      3328
#define XB_TOPGEN   3392
#define XCD_BAR_WORDS 3456
#define XB_SPIN_CAP (1u << 18)

__device__ __forceinline__ unsigned xb_ld(unsigned* p)              { return __hip_atomic_load(p, __ATOMIC_RELAXED, __HIP_MEMORY_SCOPE_AGENT); }
__device__ __forceinline__ unsigned xb_add(unsigned* p, unsigned v) { return __hip_atomic_fetch_add(p, v, __ATOMIC_RELAXED, __HIP_MEMORY_SCOPE_AGENT); }
__device__ __forceinline__ unsigned xb_xcc_id() { return (unsigned)__builtin_amdgcn_s_getreg((3 << 11) | 20) & 0xFu; }
#define XB_SPIN(cond, bar) do { unsigned _sp = 0; while (cond) { __builtin_amdgcn_s_sleep(1); \
    if ((++_sp & 255u) == 0u) { if (xb_ld(&(bar)[XB_TMO])) break; if (_sp > XB_SPIN_CAP) { atomicAdd(&(bar)[XB_TMO], 1u); break; } } } } while (0)

struct XcdBarrier {
    unsigned* bar; unsigned x;
    volatile LAS unsigned* st;
};

__device__ __forceinline__ XcdBarrier xcd_barrier_post(unsigned* bar, volatile LAS unsigned* st) {
    XcdBarrier b; b.bar = bar; b.x = xb_xcc_id(); b.st = st;
    if (threadIdx.x == 0) (void)xb_add(&bar[XB_XCNT(b.x)], 1u);
    return b;
}
__device__ __forceinline__ void xcd_barrier_complete(unsigned* bar, unsigned x, unsigned& nloc, unsigned& nx) {
    const unsigned G = gridDim.x * gridDim.y * gridDim.z;
    unsigned sum, cnt, mine, sp = 0u;
    for (;;) {
        sum = 0u; cnt = 0u; mine = 0u;
#pragma unroll
        for (unsigned j = 0; j < 16; ++j) { const unsigned c = xb_ld(&bar[XB_XCNT(j)]); sum += c; cnt += (c > 0u) ? 1u : 0u; mine = (j == x) ? c : mine; }
        if (sum == G) break;
        __builtin_amdgcn_s_sleep(1);
        if ((++sp & 255u) == 0u) { if (xb_ld(&bar[XB_TMO])) break; if (sp > XB_SPIN_CAP) { atomicAdd(&bar[XB_TMO], 1u); break; } }
    }
    nloc = mine > 0u ? mine : 1u; nx = cnt > 0u ? cnt : 1u;
}

__device__ __forceinline__ void xcd_barrier(const XcdBarrier& b) {
    asm volatile("s_waitcnt vmcnt(0)" ::: "memory");
    __syncthreads();
    if (threadIdx.x == 0) {
        unsigned* bar = b.bar;
        __builtin_amdgcn_s_waitcnt(0);
        unsigned nloc = b.st[0], nx = b.st[1];
        if (nloc == 0u) { xcd_barrier_complete(bar, b.x, nloc, nx); b.st[0] = nloc; b.st[1] = nx; }
        const unsigned old = xb_add(&bar[XB_XSUB(b.x)], 1u);
        const unsigned gen = old / nloc;
        if (old + 1u == (gen + 1u) * nloc) {
            __builtin_amdgcn_fence(__ATOMIC_RELEASE, "agent");
            asm volatile("s_waitcnt vmcnt(0)" ::: "memory");
            const unsigned og = xb_add(&bar[XB_TOP], 1u);
            const unsigned tg = og / nx;
            if (og + 1u == (tg + 1u) * nx) xb_add(&bar[XB_TOPGEN], 1u);
            else XB_SPIN(xb_ld(&bar[XB_TOPGEN]) == tg, bar);
            __builtin_amdgcn_fence(__ATOMIC_ACQUIRE, "agent");
            xb_add(&bar[XB_XGEN(b.x)], 1u);
            asm volatile("s_waitcnt vmcnt(0)" ::: "memory");
        } else {
            XB_SPIN(xb_ld(&bar[XB_XGEN(b.x)]) == gen, bar);
            __builtin_amdgcn_fence(__ATOMIC_ACQUIRE, "agent");
            asm volatile("s_waitcnt vmcnt(0)" ::: "memory");
        }
    }
    __syncthreads();
}
constexpr int NWAVES = 8;
constexpr int RING_BYTES = 131072;
constexpr int LDSCTL_OFF = RING_BYTES, MISC_OFF = LDSCTL_OFF + 320;
constexpr int LDS_BYTES = 147456;
struct Args { const float* in[19]; float* out; unsigned char* ws; int ph_lo, ph_hi; };
struct Frame {
    LAS unsigned char* lds; volatile LAS unsigned* MISC; unsigned* ctl;
    int tid, lane, wave, vcu, G;
    const float *x_prompt, *x_sample, *state_conv, *state_delta, *cache_k, *cache_v, *c_prompt, *c_sample, *w_ada, *b_ada, *w_in, *conv_w, *a_log, *dt_bias, *norm_a, *sinks, *w_out, *ln_g, *ln_b;
    float* out; unsigned char* ws;
};
__device__ __forceinline__ float wave_sum(float v) {
#pragma unroll
    for (int o = 1; o < 64; o <<= 1) v += __shfl_xor(v, o);
    return v;
}
__device__ __forceinline__ void p0_transpose_item(const float* W, int K, int N, int nblk, bf16_t* WT, LAS float* scr, int item, int lane) {
    const int kb = item / nblk, nb = item % nblk, k0 = 64 * kb, n0 = 32 * nb;
    const int nsrc = n0 + (lane & 31);
#pragma unroll 8
    for (int i = 0; i < 32; ++i) { const int kk = 2 * i + (lane >> 5); scr[kk * 33 + (lane & 31)] = nsrc < N ? W[(size_t)(k0 + kk) * N + nsrc] : 0.f; }
    LDS_WAIT(); asm volatile("" ::: "memory");
    const int c = lane & 7;
#pragma unroll
    for (int j = 0; j < 4; ++j) { const int n = (lane >> 3) + 8 * j; const LAS float* s = scr + (8 * c) * 33 + n;
        u32x4 o; o.x = pk2(s[0 * 33], s[1 * 33]); o.y = pk2(s[2 * 33], s[3 * 33]); o.z = pk2(s[4 * 33], s[5 * 33]); o.w = pk2(s[6 * 33], s[7 * 33]);
        *(u32x4*)(WT + (size_t)(n0 + n) * K + k0 + 8 * c) = o; }
    LDS_WAIT(); asm volatile("" ::: "memory");
}
__device__ __forceinline__ void p0_mod_unit(Frame& F, int u) {
    const int ct = u % 48, kc = u / 48;
    LAS float* cs = (LAS float*)F.lds;
    for (int e = F.tid; e < 136 * 128; e += 512) { const int r = e >> 7, k = e & 127;
        float v = 0.f; if (r < 2) v = F.c_prompt[r * 1024 + kc * 128 + k]; else if (r < 130) v = F.c_sample[(r - 2) * 1024 + kc * 128 + k]; cs[e] = v; }
    __syncthreads();
    const int col = F.tid & 63, rg = F.wave;
    float acc[17];
#pragma unroll
    for (int i = 0; i < 17; ++i) acc[i] = 0.f;
    const float* wp = F.w_ada + (size_t)(kc * 128) * 3072 + ct * 64 + col;
    for (int k = 0; k < 128; k += 4) {
        const float w0 = wp[(size_t)(k + 0) * 3072], w1 = wp[(size_t)(k + 1) * 3072], w2 = wp[(size_t)(k + 2) * 3072], w3 = wp[(size_t)(k + 3) * 3072];
#pragma unroll
        for (int i = 0; i < 17; ++i) { const f32x4 c4 = *(const LAS f32x4*)&cs[(rg + 8 * i) * 128 + k]; acc[i] = fmaf(c4.x, w0, fmaf(c4.y, w1, fmaf(c4.z, w2, fmaf(c4.w, w3, acc[i])))); }
    }
    float* slab = (float*)(F.ws + WS_SLAB) + (size_t)kc * 130 * 3072;
#pragma unroll
    for (int i = 0; i < 17; ++i) { const int r = rg + 8 * i; if (r < 130) slab[(size_t)r * 3072 + ct * 64 + col] = acc[i]; }
    __syncthreads();
}
__device__ __forceinline__ void p0_prologue(Frame& F) {
    for (int u = F.vcu; u < 384; u += F.G) p0_mod_unit(F, u);
    LAS float* scr = (LAS float*)(F.lds + F.wave * 16384);
    const int gw = F.vcu * NWAVES + F.wave, NGW = F.G * NWAVES;
    constexpr int I_IN = 16 * (PLD / 32), I_OUT = 16 * 32;
    for (int it = gw; it < I_IN + I_OUT; it += NGW) {
        if (it < I_IN) p0_transpose_item(F.w_in, 1024, PROJ_COLS, PLD / 32, (bf16_t*)(F.ws + WS_WIN), scr, it, F.lane);
        else p0_transpose_item(F.w_out, 1024, 1024, 32, (bf16_t*)(F.ws + WS_WOUT), scr, it - I_IN, F.lane);
    }
    float* ct = (float*)(F.ws + WS_ROPE); float* st = ct + 8193 * 32;
    for (int e = F.vcu * 512 + F.tid; e < 8193 * 32; e += F.G * 512) { float c, s; rope_cs(e >> 5, e & 31, c, s); ct[e] = c; st[e] = s; }
}
__device__ __forceinline__ void p1_h(Frame& F) {
    LAS float* ms = (LAS float*)F.lds;
    const float* slab = (const float*)(F.ws + WS_SLAB);
    for (int e = F.tid; e < 4096; e += 512) { const int b = e >> 11, c = e & 2047; float s = F.b_ada[c];
#pragma unroll
        for (int kc = 0; kc < 8; ++kc) s += slab[((size_t)kc * 130 + b) * 3072 + c];
        ms[e] = s; }
    float* mod = (float*)(F.ws + WS_MOD);
    for (int e = F.vcu * 512 + F.tid; e < 130 * 3072; e += F.G * 512) { const int c = e % 3072; float s = F.b_ada[c];
#pragma unroll
        for (int kc = 0; kc < 8; ++kc) s += slab[(size_t)kc * 130 * 3072 + e];
        mod[e] = s; }
    __syncthreads();
    bf16_t* h = (bf16_t*)(F.ws + WS_H);
    const int gw = F.vcu * NWAVES + F.wave, NGW = F.G * NWAVES;
    for (int row = gw; row < MPAD; row += NGW) {
        u32x2* o8 = (u32x2*)(h + (size_t)row * 1024) + F.lane;
        if (row >= MT) {
#pragma unroll
            for (int j = 0; j < 4; ++j) o8[64 * j] = (u32x2){0u, 0u};
            continue; }
        const float* xr = row < MP ? F.x_prompt + (size_t)row * 1024 : F.x_sample + (size_t)(row - MP) * 1024;
#pragma unroll
        for (int j = 0; j < 4; ++j) {
            const int c = 4 * F.lane + 256 * j;
            const f32x4 xv = *(const f32x4*)(xr + c);
            f32x4 sh, sc;
            if (row < MP) { const int b = row >> 13; sh = *(const LAS f32x4*)&ms[b * 2048 + c]; sc = *(const LAS f32x4*)&ms[b * 2048 + 1024 + c]; }
            else { const int r = 2 + row - MP; sh = *(const f32x4*)(F.b_ada + c); sc = *(const f32x4*)(F.b_ada + 1024 + c);
#pragma unroll
                for (int kc = 0; kc < 8; ++kc) { sh += *(const f32x4*)(slab + ((size_t)kc * 130 + r) * 3072 + c); sc += *(const f32x4*)(slab + ((size_t)kc * 130 + r) * 3072 + 1024 + c); } }
            const f32x4 hv = xv * (sc + 1.0f) + sh;
            o8[64 * j] = (u32x2){pk2(hv.x, hv.y), pk2(hv.z, hv.w)};
        }
    }
}
constexpr size_t WS_QF = WS_X, WS_OF = WS_X + 16 * MiB, WS_SF = WS_X + 32 * MiB, WS_GL = 27 * MiB;
constexpr int E1_SQ = 136, E1_ST = 72;
constexpr int E1_QS = 0, E1_KS = 17408, E1_KT = 35840, E1_VT = 54272, E1_LF = 72704, E1_T1 = 91136, E1_T2 = 100352, E1_AQ = 109568, E1_YT = 118784, E1_SM = 123008;
constexpr int E1_LL = 68;
__device__ __forceinline__ bf16x8 lds_frag(const LAS unsigned char* base, int stride_el, int row0, int ks, int lane) {
    return *(const LAS bf16x8*)(base + ((row0 + (lane & 15)) * stride_el + 32 * ks + 8 * (lane >> 4)) * 2);
}
#define MFMA16(a, b, c) __builtin_amdgcn_mfma_f32_16x16x32_bf16((a), (b), (c), 0, 0, 0)
__device__ __forceinline__ void wg_barrier() { asm volatile("s_waitcnt vmcnt(0) lgkmcnt(0)" ::: "memory"); __builtin_amdgcn_s_barrier(); asm volatile("" ::: "memory"); }
__device__ __forceinline__ void lds_barrier() { asm volatile("s_waitcnt lgkmcnt(0)" ::: "memory"); __builtin_amdgcn_s_barrier(); asm volatile("" ::: "memory"); }

__device__ __forceinline__ void e1_item(Frame& F, int cidx) {
    const int tid = F.tid, lane = F.lane, w = F.wave, q4 = lane >> 4, c16 = lane & 15;
    const int bh = cidx >> 7, ch = cidx & 127, b = bh >> 2, hd = bh & 3;
    const bf16_t* proj = (const bf16_t*)(F.ws + WS_PROJ);
    const size_t rbase = (size_t)b * SEQ + (size_t)ch * 64;
    LAS unsigned char* L = F.lds;
    LAS float* SM = (LAS float*)(L + E1_SM);
    if (w == 0) {
        const float pb = bf2f(proj[(rbase + lane) * PLD + OFF_A_BETA + hd]), pd = bf2f(proj[(rbase + lane) * PLD + OFF_A_DECAY + hd]);
        const float bt = sigmoidf_(pb);
        float G = -__expf(F.a_log[hd]) * softplusf_(pd + F.dt_bias[hd]);
#pragma unroll
        for (int o = 1; o < 64; o <<= 1) { const float t = __shfl_up(G, o); if (lane >= o) G += t; }
        const float Glast = __shfl(G, 63);
        const float eg = __expf(G);
        SM[lane] = G; SM[64 + lane] = bt; SM[128 + lane] = eg; SM[192 + lane] = __expf(Glast - G); SM[256 + lane] = bt * eg;
        if (lane == 63) ((float*)(F.ws + WS_GL))[cidx] = eg;
    }
    {
        const int cg = tid & 15, tp = tid >> 4;
#pragma unroll
        for (int part = 0; part < 3; ++part) {
            const int col0 = part * 512 + hd * 128 + 8 * cg;
            float wj[4][8];
#pragma unroll
            for (int j = 0; j < 4; ++j) { const f32x4 a = *(const f32x4*)(F.conv_w + j * A_QKV + col0), bq = *(const f32x4*)(F.conv_w + j * A_QKV + col0 + 4);
                wj[j][0] = a.x; wj[j][1] = a.y; wj[j][2] = a.z; wj[j][3] = a.w; wj[j][4] = bq.x; wj[j][5] = bq.y; wj[j][6] = bq.z; wj[j][7] = bq.w; }
            float rows[5][8];
#pragma unroll
            for (int i = 0; i < 5; ++i) {
                const int tl = ch * 64 + 2 * tp - 3 + i;
                bf16x8 v = (bf16x8){0, 0, 0, 0, 0, 0, 0, 0};
                if (tl >= 0) v = *(const bf16x8*)(proj + ((size_t)b * SEQ + tl) * PLD + col0);
#pragma unroll
                for (int e = 0; e < 8; ++e) rows[i][e] = bf2f((bf16_t)v[e]);
            }
            if (ch == 127 && tp == 31) {
#pragma unroll
                for (int i = 0; i < 3; ++i)
#pragma unroll
                    for (int e = 0; e < 8; ++e) F.out[O_CONVP + ((size_t)b * 3 + i) * A_QKV + col0 + e] = rows[2 + i][e];
            }
            float val[2][8]; float ss[2] = {0.f, 0.f};
#pragma unroll
            for (int tt = 0; tt < 2; ++tt)
#pragma unroll
                for (int e = 0; e < 8; ++e) { float a = 0.f;
#pragma unroll
                    for (int j = 0; j < 4; ++j) a = fmaf(rows[tt + j][e], wj[j][e], a);
                    a = siluf(a); val[tt][e] = a; ss[tt] = fmaf(a, a, ss[tt]); }
            if (part < 2) {
#pragma unroll
                for (int tt = 0; tt < 2; ++tt) {
                    float s = ss[tt]; s += __shfl_xor(s, 1); s += __shfl_xor(s, 2); s += __shfl_xor(s, 4); s += __shfl_xor(s, 8);
                    const float sc = rsqrtf(s + L2_EPS) * (part == 0 ? 0.08838834764831845f : 1.f);
#pragma unroll
                    for (int e = 0; e < 8; ++e) val[tt][e] *= sc;
                }
            }
            if (part < 2) {
                LAS unsigned char* dst = L + (part == 0 ? E1_QS : E1_KS);
#pragma unroll
                for (int tt = 0; tt < 2; ++tt) { u32x4 o; o.x = pk2(val[tt][0], val[tt][1]); o.y = pk2(val[tt][2], val[tt][3]); o.z = pk2(val[tt][4], val[tt][5]); o.w = pk2(val[tt][6], val[tt][7]);
                    *(LAS u32x4*)(dst + ((2 * tp + tt) * E1_SQ + 8 * cg) * 2) = o; }
            }
            if (part >= 1) {
                LAS unsigned char* dst = L + (part == 1 ? E1_KT : E1_VT);
#pragma unroll
                for (int e = 0; e < 8; ++e) *(LAS unsigned*)(dst + ((8 * cg + e) * E1_ST + 2 * tp) * 2) = pk2(val[0][e], val[1][e]);
            }
        }
    }
    lds_barrier();
    {
        LAS float* Lf = (LAS float*)(L + E1_LF);
#pragma unroll 1
        for (int jb = w; jb < 32; jb += 8) {
            const int which = jb >> 4, mi = (jb >> 2) & 3, ni = jb & 3;
            f32x4 acc = (f32x4){0.f, 0.f, 0.f, 0.f};
            if (ni <= mi) {
#pragma unroll
                for (int ks = 0; ks < 4; ++ks) acc = MFMA16(lds_frag(L + (which ? E1_QS : E1_KS), E1_SQ, 16 * mi, ks, lane), lds_frag(L + E1_KS, E1_SQ, 16 * ni, ks, lane), acc);
            }
            const int i = 16 * ni + c16; const float Gi = SM[i];
#pragma unroll
            for (int r = 0; r < 4; ++r) {
                const int t = 16 * mi + 4 * q4 + r; const float Gt = SM[t];
                const float dec = __expf(fminf(Gt - Gi, 0.f));
                if (which == 0) Lf[t * E1_LL + i] = (t > i) ? SM[64 + t] * acc[r] * dec : 0.f;
                else *(LAS bf16_t*)(L + E1_AQ + (t * E1_ST + i) * 2) = f2bf((t >= i) ? acc[r] * dec : 0.f);
            }
        }
    }
    lds_barrier();
    {
        LAS float* Lf = (LAS float*)(L + E1_LF); LAS float* Yt = (LAS float*)(L + E1_YT);
        if (w == 0) {
            const int bb = lane >> 4, j = lane & 15;
            float x[16];
#pragma unroll
            for (int t = 0; t < 16; ++t) { float a = (t == j) ? 1.f : 0.f;
#pragma unroll
                for (int i = 0; i < t; ++i) a = fmaf(-Lf[(16 * bb + t) * E1_LL + 16 * bb + i], x[i], a);
                x[t] = a; }
            asm volatile("s_waitcnt lgkmcnt(0)" ::: "memory");
#pragma unroll
            for (int t = 0; t < 16; ++t) Lf[(16 * bb + t) * E1_LL + 16 * bb + j] = x[t];
        }
        lds_barrier();
        {
            const int p = tid >> 8, r = (tid >> 4) & 15, c = tid & 15, a = 32 * p;
            float y = 0.f;
#pragma unroll
            for (int k = 0; k < 16; ++k) y = fmaf(Lf[(a + 16 + r) * E1_LL + a + k], Lf[(a + k) * E1_LL + a + c], y);
            Yt[p * 16 * 33 + r * 33 + c] = y;
            lds_barrier();
            float pv = 0.f;
#pragma unroll
            for (int k = 0; k < 16; ++k) pv = fmaf(Lf[(a + 16 + r) * E1_LL + a + 16 + k], Yt[p * 16 * 33 + k * 33 + c], pv);
            lds_barrier();
            Lf[(a + 16 + r) * E1_LL + a + c] = -pv;
        }
        lds_barrier();
        {
            float y[2], pv[2];
#pragma unroll
            for (int u = 0; u < 2; ++u) { const int o = tid + 512 * u, r = o >> 5, c = o & 31; float s = 0.f;
#pragma unroll 8
                for (int k = 0; k < 32; ++k) s = fmaf(Lf[(32 + r) * E1_LL + k], Lf[k * E1_LL + c], s);
                y[u] = s; }
#pragma unroll
            for (int u = 0; u < 2; ++u) { const int o = tid + 512 * u; Yt[(o >> 5) * 33 + (o & 31)] = y[u]; }
            lds_barrier();
#pragma unroll
            for (int u = 0; u < 2; ++u) { const int o = tid + 512 * u, r = o >> 5, c = o & 31; float s = 0.f;
#pragma unroll 8
                for (int k = 0; k < 32; ++k) s = fmaf(Lf[(32 + r) * E1_LL + 32 + k], Yt[k * 33 + c], s);
                pv[u] = s; }
            lds_barrier();
#pragma unroll
            for (int u = 0; u < 2; ++u) { const int o = tid + 512 * u; Lf[(32 + (o >> 5)) * E1_LL + (o & 31)] = -pv[u]; }
        }
        lds_barrier();
#pragma unroll
        for (int u = 0; u < 8; ++u) { const int o = tid + 512 * u, t = o >> 6, i = o & 63; const float tv = Lf[t * E1_LL + i];
            *(LAS bf16_t*)(L + E1_T1 + (t * E1_ST + i) * 2) = f2bf(tv * SM[256 + i]); *(LAS bf16_t*)(L + E1_T2 + (t * E1_ST + i) * 2) = f2bf(tv * SM[64 + i]); }
    }
    lds_barrier();
    {
#pragma unroll 1
        for (int jb = w; jb < 64; jb += 8) {
            const int which = jb >> 5, mi = (jb >> 3) & 3, ni = jb & 7;
            f32x4 acc = (f32x4){0.f, 0.f, 0.f, 0.f};
#pragma unroll
            for (int ks = 0; ks < 2; ++ks) acc = MFMA16(lds_frag(L + (which ? E1_T2 : E1_T1), E1_ST, 16 * mi, ks, lane), lds_frag(L + (which ? E1_VT : E1_KT), E1_ST, 16 * ni, ks, lane), acc);
            *(LAS u32x2*)(L + (which ? E1_LF : E1_KS) + ((16 * ni + c16) * E1_ST + 16 * mi + 4 * q4) * 2) = (u32x2){pk2(acc[0], acc[1]), pk2(acc[2], acc[3])};
        }
    }
    lds_barrier();
    {
        const int d = tid >> 2, t0 = (tid & 3) * 16;
        LAS bf16_t* p = (LAS bf16_t*)(L + E1_KT) + d * E1_ST + t0;
#pragma unroll
        for (int e = 0; e < 16; ++e) p[e] = f2bf(bf2f(p[e]) * SM[192 + t0 + e]);
    }
    lds_barrier();
    {
        const LAS unsigned char* WT = L + E1_KS; const LAS unsigned char* UT = L + E1_LF; const LAS unsigned char* KdT = L + E1_KT; const LAS unsigned char* AQ = L + E1_AQ;
        bf16_t* MF = (bf16_t*)F.out + (size_t)cidx * 16384;
        bf16_t* BF = (bf16_t*)((unsigned char*)F.out + 32 * MiB) + (size_t)cidx * 16384;
        bf16_t* QF = (bf16_t*)(F.ws + WS_QF) + (size_t)cidx * 8192;
        bf16_t* OFp = (bf16_t*)(F.ws + WS_OF) + (size_t)cidx * 8192;
        {
            const bf16x8 b0 = lds_frag(KdT, E1_ST, 16 * w, 0, lane), b1 = lds_frag(KdT, E1_ST, 16 * w, 1, lane);
#pragma unroll
            for (int kp = 0; kp < 4; ++kp) {
                f32x4 a0 = (f32x4){0.f, 0.f, 0.f, 0.f}, a1 = a0;
                a0 = MFMA16(lds_frag(WT, E1_ST, 16 * (2 * kp), 0, lane), b0, a0); a0 = MFMA16(lds_frag(WT, E1_ST, 16 * (2 * kp), 1, lane), b1, a0);
                a1 = MFMA16(lds_frag(WT, E1_ST, 16 * (2 * kp + 1), 0, lane), b0, a1); a1 = MFMA16(lds_frag(WT, E1_ST, 16 * (2 * kp + 1), 1, lane), b1, a1);
                *(u32x4*)(MF + ((size_t)(w * 4 + kp) * 64 + lane) * 8) = (u32x4){pk2(-a0[0], -a0[1]), pk2(-a0[2], -a0[3]), pk2(-a1[0], -a1[1]), pk2(-a1[2], -a1[3])};
            }
        }
        {
            const bf16x8 b0 = lds_frag(UT, E1_ST, 16 * w, 0, lane), b1 = lds_frag(UT, E1_ST, 16 * w, 1, lane);
#pragma unroll
            for (int kp = 0; kp < 4; ++kp) {
                f32x4 a0 = (f32x4){0.f, 0.f, 0.f, 0.f}, a1 = a0;
                a0 = MFMA16(lds_frag(KdT, E1_ST, 16 * (2 * kp), 0, lane), b0, a0); a0 = MFMA16(lds_frag(KdT, E1_ST, 16 * (2 * kp), 1, lane), b1, a0);
                a1 = MFMA16(lds_frag(KdT, E1_ST, 16 * (2 * kp + 1), 0, lane), b0, a1); a1 = MFMA16(lds_frag(KdT, E1_ST, 16 * (2 * kp + 1), 1, lane), b1, a1);
                *(u32x4*)(BF + ((size_t)(w * 64 + lane) * 8 + 2 * kp) * 4) = (u32x4){pk2(a0[0], a0[1]), pk2(a0[2], a0[3]), pk2(a1[0], a1[1]), pk2(a1[2], a1[3])};
            }
#pragma unroll
            for (int kp = 0; kp < 2; ++kp) {
                f32x4 a0 = (f32x4){0.f, 0.f, 0.f, 0.f}, a1 = a0;
                a0 = MFMA16(lds_frag(AQ, E1_ST, 16 * (2 * kp), 0, lane), b0, a0); a0 = MFMA16(lds_frag(AQ, E1_ST, 16 * (2 * kp), 1, lane), b1, a0);
                a1 = MFMA16(lds_frag(AQ, E1_ST, 16 * (2 * kp + 1), 0, lane), b0, a1); a1 = MFMA16(lds_frag(AQ, E1_ST, 16 * (2 * kp + 1), 1, lane), b1, a1);
                *(u32x4*)(OFp + ((size_t)(w * 64 + lane) * 4 + 2 * kp) * 4) = (u32x4){pk2(a0[0], a0[1]), pk2(a0[2], a0[3]), pk2(a1[0], a1[1]), pk2(a1[2], a1[3])};
            }
        }
        {
            const int ni = w & 3, t = 16 * ni + c16; const float eg = SM[128 + t];
            const bf16x8 b0 = lds_frag(AQ, E1_ST, 16 * ni, 0, lane), b1 = lds_frag(AQ, E1_ST, 16 * ni, 1, lane);
#pragma unroll
            for (int kk = 0; kk < 2; ++kk) {
                const int ks = 2 * (w >> 2) + kk;
                f32x4 a0 = (f32x4){0.f, 0.f, 0.f, 0.f}, a1 = a0;
                a0 = MFMA16(lds_frag(WT, E1_ST, 16 * (2 * ks), 0, lane), b0, a0); a0 = MFMA16(lds_frag(WT, E1_ST, 16 * (2 * ks), 1, lane), b1, a0);
                a1 = MFMA16(lds_frag(WT, E1_ST, 16 * (2 * ks + 1), 0, lane), b0, a1); a1 = MFMA16(lds_frag(WT, E1_ST, 16 * (2 * ks + 1), 1, lane), b1, a1);
                const u32x2 q0 = *(const LAS u32x2*)(L + E1_QS + (t * E1_SQ + 16 * (2 * ks) + 4 * q4) * 2), q1 = *(const LAS u32x2*)(L + E1_QS + (t * E1_SQ + 16 * (2 * ks + 1) + 4 * q4) * 2);
                const float v0 = eg * __uint_as_float(q0.x << 16) - a0[0], v1 = eg * __uint_as_float(q0.x & 0xffff0000u) - a0[1], v2 = eg * __uint_as_float(q0.y << 16) - a0[2], v3 = eg * __uint_as_float(q0.y & 0xffff0000u) - a0[3];
                const float v4 = eg * __uint_as_float(q1.x << 16) - a1[0], v5 = eg * __uint_as_float(q1.x & 0xffff0000u) - a1[1], v6 = eg * __uint_as_float(q1.y << 16) - a1[2], v7 = eg * __uint_as_float(q1.y & 0xffff0000u) - a1[3];
                *(u32x4*)(QF + ((size_t)(ni * 4 + ks) * 64 + lane) * 8) = (u32x4){pk2(v0, v1), pk2(v2, v3), pk2(v4, v5), pk2(v6, v7)};
            }
        }
    }
    wg_barrier();
}

__device__ __forceinline__ void scan_unit(Frame& F, int bh, int s) {
    const int lane = F.lane, i = F.wave;
    LAS unsigned char* L = F.lds;
    const bf16_t* MF = (const bf16_t*)F.out; const bf16_t* BF = (const bf16_t*)((unsigned char*)F.out + 32 * MiB);
    bf16_t* SF = (bf16_t*)(F.ws + WS_SF); const float* GL = (const float*)(F.ws + WS_GL);
    for (int e = F.tid; e < 2048; e += 512) ((LAS unsigned*)L)[e] = 0u;
    f32x4 acc = (f32x4){0.f, 0.f, 0.f, 0.f};
    const size_t c0 = (size_t)bh * 128;
    constexpr int PF = 4;
    bf16x8 A[PF][4]; u32x2 Bc[PF]; float gl[PF];
#define SCAN_LOAD(slot, cc) do { const size_t ci_ = c0 + (cc); _Pragma("unroll") for (int ks = 0; ks < 4; ++ks) A[slot][ks] = *(const bf16x8*)(MF + ((ci_ * 8 + i) * 4 + ks) * 512 + lane * 8); \
        Bc[slot] = *(const u32x2*)(BF + ((ci_ * 8 + s) * 64 + lane) * 32 + i * 4); gl[slot] = GL[ci_]; } while (0)
#pragma unroll
    for (int p = 0; p < PF; ++p) SCAN_LOAD(p, p);
    lds_barrier();
    for (int cb = 0; cb < 128; cb += PF) {
#pragma unroll
        for (int p = 0; p < PF; ++p) {
            const int c = cb + p, cur = p & 1;
            const size_t ci = c0 + c;
            bf16x8 Sf[4];
#pragma unroll
            for (int ks = 0; ks < 4; ++ks) Sf[ks] = *(const LAS bf16x8*)(L + cur * 4096 + (ks * 64 + lane) * 16);
            if (i < 4) *(bf16x8*)(SF + ((ci * 8 + s) * 4 + i) * 512 + lane * 8) = *(const LAS bf16x8*)(L + cur * 4096 + (i * 64 + lane) * 16);
            const float g = gl[p];
            acc[0] = fmaf(g, acc[0], __uint_as_float(Bc[p].x << 16)); acc[1] = fmaf(g, acc[1], __uint_as_float(Bc[p].x & 0xffff0000u));
            acc[2] = fmaf(g, acc[2], __uint_as_float(Bc[p].y << 16)); acc[3] = fmaf(g, acc[3], __uint_as_float(Bc[p].y & 0xffff0000u));
#pragma unroll
            for (int ks = 0; ks < 4; ++ks) acc = MFMA16(A[p][ks], Sf[ks], acc);
            *(LAS u32x2*)(L + (cur ^ 1) * 4096 + ((i >> 1) * 64 + lane) * 16 + (i & 1) * 8) = (u32x2){pk2(acc[0], acc[1]), pk2(acc[2], acc[3])};
            if (c + PF < 128) SCAN_LOAD(p, c + PF);
            lds_barrier();
        }
    }
#undef SCAN_LOAD
    float* dp = F.out + O_DELTAP + (size_t)bh * 128 * 128;
#pragma unroll
    for (int r = 0; r < 4; ++r) dp[(size_t)(16 * i + 4 * (lane >> 4) + r) * 128 + 16 * s + (lane & 15)] = acc[r];
    wg_barrier();
}

__device__ __forceinline__ void o_item(Frame& F, int cidx) {
    const int tid = F.tid, lane = F.lane, w = F.wave, q4 = lane >> 4, c16 = lane & 15;
    const int bh = cidx >> 7, ch = cidx & 127, b = bh >> 2, hd = bh & 3;
    const bf16_t* QF = (const bf16_t*)(F.ws + WS_QF) + (size_t)cidx * 8192; const bf16_t* OFp = (const bf16_t*)(F.ws + WS_OF) + (size_t)cidx * 8192;
    const bf16_t* SF = (const bf16_t*)(F.ws + WS_SF) + (size_t)cidx * 16384;
    LAS float* Of = (LAS float*)F.lds;
    bf16x8 Sf[4];
#pragma unroll
    for (int ks = 0; ks < 4; ++ks) Sf[ks] = *(const bf16x8*)(SF + ((size_t)(w * 4 + ks) * 64 + lane) * 8);
    const u32x4 o01 = *(const u32x4*)(OFp + ((size_t)(w * 64 + lane) * 4) * 4), o23 = *(const u32x4*)(OFp + ((size_t)(w * 64 + lane) * 4 + 2) * 4);
    const unsigned ow[8] = {o01.x, o01.y, o01.z, o01.w, o23.x, o23.y, o23.z, o23.w};
#pragma unroll
    for (int mt = 0; mt < 4; ++mt) {
        f32x4 acc = (f32x4){__uint_as_float(ow[2 * mt] << 16), __uint_as_float(ow[2 * mt] & 0xffff0000u), __uint_as_float(ow[2 * mt + 1] << 16), __uint_as_float(ow[2 * mt + 1] & 0xffff0000u)};
#pragma unroll
        for (int ks = 0; ks < 4; ++ks) acc = MFMA16(*(const bf16x8*)(QF + ((size_t)(mt * 4 + ks) * 64 + lane) * 8), Sf[ks], acc);
#pragma unroll
        for (int r = 0; r < 4; ++r) Of[(16 * mt + 4 * q4 + r) * 132 + 16 * w + c16] = acc[r];
    }
    lds_barrier();
    {
        const int t = tid >> 3, cs = tid & 7;
        float v[16]; float ss = 0.f;
#pragma unroll
        for (int u = 0; u < 4; ++u) { const f32x4 x = *(const LAS f32x4*)&Of[t * 132 + 16 * cs + 4 * u]; v[4 * u] = x.x; v[4 * u + 1] = x.y; v[4 * u + 2] = x.z; v[4 * u + 3] = x.w; ss += x.x * x.x + x.y * x.y + x.z * x.z + x.w * x.w; }
        ss += __shfl_xor(ss, 1); ss += __shfl_xor(ss, 2); ss += __shfl_xor(ss, 4);
        const float rs = rsqrtf(ss * (1.f / 128.f) + RMS_EPS);
        const size_t row = (size_t)b * SEQ + (size_t)ch * 64 + t;
        const bf16_t* zp = (const bf16_t*)(F.ws + WS_PROJ) + row * PLD + OFF_A_Z + hd * 128 + 16 * cs;
        const bf16x8 z0 = *(const bf16x8*)zp, z1 = *(const bf16x8*)(zp + 8);
        float o[16];
#pragma unroll
        for (int e = 0; e < 16; ++e) { const float z = bf2f((bf16_t)(e < 8 ? z0[e] : z1[e - 8])); o[e] = v[e] * rs * F.norm_a[16 * cs + e] * siluf(z); }
        bf16_t* mp = (bf16_t*)(F.ws + WS_H) + row * 1024 + hd * 128 + 16 * cs;
        *(u32x4*)mp = (u32x4){pk2(o[0], o[1]), pk2(o[2], o[3]), pk2(o[4], o[5]), pk2(o[6], o[7])};
        *(u32x4*)(mp + 8) = (u32x4){pk2(o[8], o[9]), pk2(o[10], o[11]), pk2(o[12], o[13]), pk2(o[14], o[15])};
    }
    wg_barrier();
}
typedef float f32x16 __attribute__((ext_vector_type(16)));
#define MFMA32(a, b, c) __builtin_amdgcn_mfma_f32_32x32x16_bf16((a), (b), (c), 0, 0, 0)
constexpr int SW_KST = 72, SW_VST = 260;
constexpr int SW_K = 0, SW_VT = 36864, SW_INV = SW_VT + 33280;
__device__ __forceinline__ void swa_item(Frame& F, int item) {
    const int tid = F.tid, lane = F.lane, w = F.wave, l31 = lane & 31, hh = lane >> 5;
    const int nblk = item & 63, kvh = (item >> 6) & 1, b = item >> 7;
    const bf16_t* proj = (const bf16_t*)(F.ws + WS_PROJ);
    const float* cosT = (const float*)(F.ws + WS_ROPE); const float* sinT = cosT + 8193 * 32;
    LAS unsigned char* L = F.lds;
    {
        const int j = tid >> 1, half = tid & 1;
        const int pos = (nblk - 1) * 128 + j;
        float k1[16], k2[16];
        if (pos >= 0) {
            const bf16_t* kp = proj + ((size_t)b * SEQ + pos) * PLD + OFF_B_K + kvh * 64 + 16 * half;
            const bf16x8 a0 = *(const bf16x8*)kp, a1 = *(const bf16x8*)(kp + 8), c0 = *(const bf16x8*)(kp + 32), c1 = *(const bf16x8*)(kp + 40);
#pragma unroll
            for (int e = 0; e < 8; ++e) { k1[e] = bf2f((bf16_t)a0[e]); k1[8 + e] = bf2f((bf16_t)a1[e]); k2[e] = bf2f((bf16_t)c0[e]); k2[8 + e] = bf2f((bf16_t)c1[e]); }
            float r1[16], r2[16];
#pragma unroll
            for (int u = 0; u < 4; ++u) { const f32x4 cc = *(const f32x4*)(cosT + pos * 32 + 16 * half + 4 * u), sn = *(const f32x4*)(sinT + pos * 32 + 16 * half + 4 * u);
#pragma unroll
                for (int e = 0; e < 4; ++e) { const float c = cc[e], s = sn[e], x1 = k1[4 * u + e], x2 = k2[4 * u + e]; r1[4 * u + e] = x1 * c - x2 * s; r2[4 * u + e] = x2 * c + x1 * s; } }
#pragma unroll
            for (int e = 0; e < 16; ++e) { k1[e] = r1[e]; k2[e] = r2[e]; }
            if (nblk == 63 && j >= 128) {
                float* ko = F.out + O_KP + (((size_t)b * WINDOW + (j - 128)) * 2 + kvh) * 64;
#pragma unroll
                for (int u = 0; u < 4; ++u) { *(f32x4*)(ko + 16 * half + 4 * u) = (f32x4){k1[4 * u], k1[4 * u + 1], k1[4 * u + 2], k1[4 * u + 3]}; *(f32x4*)(ko + 32 + 16 * half + 4 * u) = (f32x4){k2[4 * u], k2[4 * u + 1], k2[4 * u + 2], k2[4 * u + 3]}; }
            }
        } else {
#pragma unroll
            for (int e = 0; e < 16; ++e) { k1[e] = 0.f; k2[e] = 0.f; }
        }
        LAS unsigned char* kd = L + SW_K + (j * SW_KST + 16 * half) * 2;
        *(LAS u32x4*)kd = (u32x4){pk2(k1[0], k1[1]), pk2(k1[2], k1[3]), pk2(k1[4], k1[5]), pk2(k1[6], k1[7])};
        *(LAS u32x4*)(kd + 16) = (u32x4){pk2(k1[8], k1[9]), pk2(k1[10], k1[11]), pk2(k1[12], k1[13]), pk2(k1[14], k1[15])};
        *(LAS u32x4*)(kd + 64) = (u32x4){pk2(k2[0], k2[1]), pk2(k2[2], k2[3]), pk2(k2[4], k2[5]), pk2(k2[6], k2[7])};
        *(LAS u32x4*)(kd + 80) = (u32x4){pk2(k2[8], k2[9]), pk2(k2[10], k2[11]), pk2(k2[12], k2[13]), pk2(k2[14], k2[15])};
        LAS bf16_t* vt = (LAS bf16_t*)(L + SW_VT);
        if (pos >= 0) {
            const bf16_t* vp = proj + ((size_t)b * SEQ + pos) * PLD + OFF_B_V + kvh * 64 + 32 * half;
#pragma unroll
            for (int u = 0; u < 4; ++u) { const bf16x8 v = *(const bf16x8*)(vp + 8 * u);
#pragma unroll
                for (int e = 0; e < 8; ++e) vt[(32 * half + 8 * u + e) * SW_VST + j] = (bf16_t)v[e];
                if (nblk == 63 && j >= 128) { float* vo = F.out + O_VP + (((size_t)b * WINDOW + (j - 128)) * 2 + kvh) * 64 + 32 * half + 8 * u;
                    *(f32x4*)vo = (f32x4){bf2f((bf16_t)v[0]), bf2f((bf16_t)v[1]), bf2f((bf16_t)v[2]), bf2f((bf16_t)v[3])}; *(f32x4*)(vo + 4) = (f32x4){bf2f((bf16_t)v[4]), bf2f((bf16_t)v[5]), bf2f((bf16_t)v[6]), bf2f((bf16_t)v[7])}; }
            }
        } else {
#pragma unroll
            for (int e = 0; e < 32; ++e) vt[(32 * half + e) * SW_VST + j] = (bf16_t)0;
        }
    }
    lds_barrier();
    const int hq = kvh * 4 + (w >> 1), qhalf = w & 1;
    const float sink = F.sinks[hq];
    LAS float* inv = (LAS float*)(L + SW_INV + w * 128);
#pragma unroll 1
    for (int qt = 0; qt < 2; ++qt) {
        const int a0 = 64 * qhalf + 32 * qt, a = a0 + l31, kt0 = a0 >> 5;
        const int pos = nblk * 128 + a; const size_t row = (size_t)b * SEQ + pos;
        bf16x8 qf[4];
        {
            const bf16_t* qp = proj + row * PLD + OFF_B_Q + hq * 64 + 8 * hh;
            float x[4][8];
#pragma unroll
            for (int ks = 0; ks < 4; ++ks) { const bf16x8 v = *(const bf16x8*)(qp + 16 * ks);
#pragma unroll
                for (int e = 0; e < 8; ++e) x[ks][e] = bf2f((bf16_t)v[e]); }
#pragma unroll
            for (int ks = 0; ks < 2; ++ks) {
                const float* cp = cosT + pos * 32 + 16 * ks + 8 * hh; const float* sp = sinT + pos * 32 + 16 * ks + 8 * hh;
                const f32x4 c0 = *(const f32x4*)cp, c1 = *(const f32x4*)(cp + 4), s0 = *(const f32x4*)sp, s1 = *(const f32x4*)(sp + 4);
#pragma unroll
                for (int e = 0; e < 8; ++e) { const float c = e < 4 ? c0[e & 3] : c1[e & 3], s = e < 4 ? s0[e & 3] : s1[e & 3]; const float x1 = x[ks][e], x2 = x[ks + 2][e];
                    x[ks][e] = (x1 * c - x2 * s) * 0.125f; x[ks + 2][e] = (x2 * c + x1 * s) * 0.125f; }
            }
#pragma unroll
            for (int ks = 0; ks < 4; ++ks) { const u32x4 pk = (u32x4){pk2(x[ks][0], x[ks][1]), pk2(x[ks][2], x[ks][3]), pk2(x[ks][4], x[ks][5]), pk2(x[ks][6], x[ks][7])}; qf[ks] = __builtin_bit_cast(bf16x8, pk); }
        }
        f32x16 sc[5];
#pragma unroll
        for (int kt = 0; kt < 5; ++kt) {
            f32x16 acc;
#pragma unroll
            for (int r = 0; r < 16; ++r) acc[r] = 0.f;
#pragma unroll
            for (int ks = 0; ks < 4; ++ks) { const bf16x8 kf = *(const LAS bf16x8*)(L + SW_K + ((32 * (kt0 + kt) + l31) * SW_KST + 16 * ks + 8 * hh) * 2); acc = MFMA32(kf, qf[ks], acc); }
            sc[kt] = acc;
        }
        float mx = sink;
#pragma unroll
        for (int kt = 0; kt < 5; ++kt)
#pragma unroll
            for (int r = 0; r < 16; ++r) { const int j = 32 * (kt0 + kt) + (r & 3) + 8 * (r >> 2) + 4 * hh; const int rel = a + 128 - j;
                const bool ok = rel >= 0 && rel <= 128 && (nblk > 0 || j >= 128);
                const float s = ok ? sc[kt][r] : -INFINITY; sc[kt][r] = s; mx = fmaxf(mx, s); }
        mx = fmaxf(mx, __shfl_xor(mx, 32));
        float sum = 0.f;
#pragma unroll
        for (int kt = 0; kt < 5; ++kt)
#pragma unroll
            for (int r = 0; r < 16; ++r) { const float p = __expf(sc[kt][r] - mx); sc[kt][r] = p; sum += p; }
        sum += __shfl_xor(sum, 32);
        sum += __expf(sink - mx);
        if (hh == 0) inv[l31] = 1.f / sum;
        f32x16 o[2];
#pragma unroll
        for (int dt = 0; dt < 2; ++dt)
#pragma unroll
            for (int r = 0; r < 16; ++r) o[dt][r] = 0.f;
#pragma unroll
        for (int kt = 0; kt < 5; ++kt)
#pragma unroll
            for (int s2 = 0; s2 < 2; ++s2) {
                const u32x4 pk = (u32x4){pk2(sc[kt][8 * s2], sc[kt][8 * s2 + 1]), pk2(sc[kt][8 * s2 + 2], sc[kt][8 * s2 + 3]), pk2(sc[kt][8 * s2 + 4], sc[kt][8 * s2 + 5]), pk2(sc[kt][8 * s2 + 6], sc[kt][8 * s2 + 7])};
                const bf16x8 pa = __builtin_bit_cast(bf16x8, pk);
                const int kbase = 32 * (kt0 + kt) + 16 * s2 + 4 * hh;
#pragma unroll
                for (int dt = 0; dt < 2; ++dt) {
                    const LAS unsigned char* vp = L + SW_VT + ((32 * dt + l31) * SW_VST + kbase) * 2;
                    const u32x2 v0 = *(const LAS u32x2*)vp, v1 = *(const LAS u32x2*)(vp + 16);
                    const u32x4 vv = (u32x4){v0.x, v0.y, v1.x, v1.y};
                    o[dt] = MFMA32(pa, __builtin_bit_cast(bf16x8, vv), o[dt]);
                }
            }
        asm volatile("s_waitcnt lgkmcnt(0)" ::: "memory");
#pragma unroll
        for (int r = 0; r < 16; ++r) {
            const int qq = (r & 3) + 8 * (r >> 2) + 4 * hh; const float iv = inv[qq];
            const size_t rw = (size_t)b * SEQ + nblk * 128 + a0 + qq;
#pragma unroll
            for (int dt = 0; dt < 2; ++dt) {
                const float z = bf2f(proj[rw * PLD + OFF_B_Z + hq * 64 + 32 * dt + l31]);
                ((bf16_t*)(F.ws + WS_H))[rw * 1024 + 512 + hq * 64 + 32 * dt + l31] = f2bf(o[dt][r] * iv * siluf(z));
            }
        }
        asm volatile("s_waitcnt lgkmcnt(0)" ::: "memory");
    }
    wg_barrier();
}
__global__ void __launch_bounds__(128) k_convA(const bf16_t* __restrict__ proj, const float* __restrict__ state_conv, const float* __restrict__ conv_w,
                                               const float* __restrict__ a_log, const float* __restrict__ dt_bias,
                                               float* __restrict__ qa, float* __restrict__ ka, float* __restrict__ va, float* __restrict__ beta, float* __restrict__ g, int row0) {
    const int r = row0 + blockIdx.x, hd = blockIdx.y, c = threadIdx.x;
    __shared__ float red[2][128];
    float vals[3];
#pragma unroll
    for (int part = 0; part < 3; ++part) {
        const int col = part * A_WIDTH + hd * 128 + c;
        float acc = 0.f;
#pragma unroll
        for (int j = 0; j < 4; ++j) {
            float u;
            if (r < MP) { const int t = r % SEQ, tt = t - 3 + j; u = tt >= 0 ? bf2f(proj[(size_t)(r - 3 + j) * PLD + col]) : 0.f; }
            else { const int b = r - MP; u = j < 3 ? state_conv[((size_t)b * 3 + j) * A_QKV + col] : bf2f(proj[(size_t)r * PLD + col]); }
            acc = fmaf(u, conv_w[j * A_QKV + col], acc);
        }
        vals[part] = siluf(acc);
    }
    red[0][c] = vals[0] * vals[0]; red[1][c] = vals[1] * vals[1];
    __syncthreads();
    for (int s = 64; s > 0; s >>= 1) { if (c < s) { red[0][c] += red[0][c + s]; red[1][c] += red[1][c + s]; } __syncthreads(); }
    const float rq = rsqrtf(red[0][0] + L2_EPS) * 0.08838834764831845f, rk = rsqrtf(red[1][0] + L2_EPS);
    const size_t o = (size_t)blockIdx.x * A_WIDTH + hd * 128 + c;
    qa[o] = vals[0] * rq; ka[o] = vals[1] * rk; va[o] = vals[2];
    if (c == 0) {
        beta[(size_t)blockIdx.x * 4 + hd] = sigmoidf_(bf2f(proj[(size_t)r * PLD + OFF_A_BETA + hd]));
        g[(size_t)blockIdx.x * 4 + hd] = -__expf(a_log[hd]) * softplusf_(bf2f(proj[(size_t)r * PLD + OFF_A_DECAY + hd]) + dt_bias[hd]);
    }
}

__global__ void k_conv_state(const bf16_t* __restrict__ proj, const float* __restrict__ state_conv, float* __restrict__ out) {
    const int i = blockIdx.x * blockDim.x + threadIdx.x;
    if (i < BATCH * 3 * A_QKV) { const int b = i / (3 * A_QKV), j = (i / A_QKV) % 3, c = i % A_QKV; out[O_CONVP + i] = bf2f(proj[(size_t)(b * SEQ + SEQ - 3 + j) * PLD + c]); }
    if (i < DEC_BATCH * 3 * A_QKV) { const int b = i / (3 * A_QKV), j = (i / A_QKV) % 3, c = i % A_QKV;
        out[O_CONVS + i] = j < 2 ? state_conv[((size_t)b * 3 + j + 1) * A_QKV + c] : bf2f(proj[(size_t)(MP + b) * PLD + c]); }
}

__global__ void __launch_bounds__(128) k_delta_rec(const float* __restrict__ qa, const float* __restrict__ ka, const float* __restrict__ va, const float* __restrict__ beta, const float* __restrict__ g,
                                                   const float* __restrict__ s0, float* __restrict__ s_out, float* __restrict__ oa, int row0, int T) {
    const int seq = blockIdx.x >> 2, hd = blockIdx.x & 3, e = threadIdx.x;
    __shared__ float kq[2][128];
    float S[128];
    const size_t sbase = ((size_t)(seq * 4 + hd) * 128) * 128 + e;
#pragma unroll
    for (int d = 0; d < 128; ++d) S[d] = s0 ? s0[sbase + (size_t)d * 128] : 0.f;
    for (int t = 0; t < T; ++t) {
        const size_t r = (size_t)row0 + (size_t)seq * T + t;
        __syncthreads();
        kq[0][e] = ka[r * A_WIDTH + hd * 128 + e]; kq[1][e] = qa[r * A_WIDTH + hd * 128 + e];
        __syncthreads();
        const float dec = __expf(g[r * 4 + hd]), bt = beta[r * 4 + hd], v = va[r * A_WIDTH + hd * 128 + e];
        float pred = 0.f;
#pragma unroll
        for (int d = 0; d < 128; ++d) { S[d] *= dec; pred = fmaf(kq[0][d], S[d], pred); }
        const float u = bt * (v - pred);
        float o = 0.f;
#pragma unroll
        for (int d = 0; d < 128; ++d) { S[d] = fmaf(kq[0][d], u, S[d]); o = fmaf(kq[1][d], S[d], o); }
        oa[r * A_WIDTH + hd * 128 + e] = o;
    }
#pragma unroll
    for (int d = 0; d < 128; ++d) s_out[sbase + (size_t)d * 128] = S[d];
}

__global__ void __launch_bounds__(128) k_rms_gate(const float* __restrict__ oa, const bf16_t* __restrict__ proj, const float* __restrict__ norm_a, bf16_t* __restrict__ mix, int row0) {
    const int r = row0 + blockIdx.x, hd = blockIdx.y, e = threadIdx.x;
    __shared__ float red[128];
    const float o = oa[(size_t)blockIdx.x * A_WIDTH + hd * 128 + e];
    red[e] = o * o; __syncthreads();
    for (int s = 64; s > 0; s >>= 1) { if (e < s) red[e] += red[e + s]; __syncthreads(); }
    const float rs = rsqrtf(red[0] * (1.f / 128.f) + RMS_EPS);
    const float z = bf2f(proj[(size_t)r * PLD + OFF_A_Z + hd * 128 + e]);
    mix[(size_t)r * 1024 + hd * 128 + e] = f2bf(o * rs * norm_a[e] * siluf(z));
}

__global__ void k_rope(const bf16_t* __restrict__ proj, float* __restrict__ qb, float* __restrict__ kb, float* __restrict__ vb, int row0) {
    const int r = row0 + blockIdx.x; const int lr = blockIdx.x;
    const int pos = r < MP ? r % SEQ : PAST_LEN;
    for (int idx = threadIdx.x; idx < 10 * 32; idx += blockDim.x) {
        const int hh = idx >> 5, i = idx & 31;
        float c, s; rope_cs(pos, i, c, s);
        if (hh < 8) {
            const float x1 = bf2f(proj[(size_t)r * PLD + OFF_B_Q + hh * 64 + i]), x2 = bf2f(proj[(size_t)r * PLD + OFF_B_Q + hh * 64 + 32 + i]);
            qb[(size_t)lr * 512 + hh * 64 + i] = (x1 * c - x2 * s) * 0.125f; qb[(size_t)lr * 512 + hh * 64 + 32 + i] = (x2 * c + x1 * s) * 0.125f;
        } else {
            const int kh = hh - 8;
            const float x1 = bf2f(proj[(size_t)r * PLD + OFF_B_K + kh * 64 + i]), x2 = bf2f(proj[(size_t)r * PLD + OFF_B_K + kh * 64 + 32 + i]);
            kb[(size_t)lr * 128 + kh * 64 + i] = x1 * c - x2 * s; kb[(size_t)lr * 128 + kh * 64 + 32 + i] = x2 * c + x1 * s;
        }
    }
    for (int idx = threadIdx.x; idx < 128; idx += blockDim.x) vb[(size_t)lr * 128 + idx] = bf2f(proj[(size_t)r * PLD + OFF_B_V + idx]);
}
__global__ void k_cache_out(const float* __restrict__ kb, const float* __restrict__ vb, const float* __restrict__ ck, const float* __restrict__ cv, float* __restrict__ out) {
    const int i = blockIdx.x * blockDim.x + threadIdx.x;
    if (i < DEC_BATCH * WINDOW * 128) { const int b = i / (WINDOW * 128), w = (i / 128) % WINDOW, c = i % 128;
        out[O_KS + i] = w < WINDOW - 1 ? ck[((size_t)b * WINDOW + w + 1) * 128 + c] : kb[(size_t)b * 128 + c];
        out[O_VS + i] = w < WINDOW - 1 ? cv[((size_t)b * WINDOW + w + 1) * 128 + c] : vb[(size_t)b * 128 + c]; }
}

__global__ void __launch_bounds__(64) k_swa(const float* __restrict__ qb, const float* __restrict__ kb, const float* __restrict__ vb, const float* __restrict__ ck, const float* __restrict__ cv,
                                           const float* __restrict__ sinks, const bf16_t* __restrict__ proj, bf16_t* __restrict__ mix, int row0) {
    const int r = row0 + blockIdx.x, lr = blockIdx.x, hh = blockIdx.y, kvh = hh >> 2, lane = threadIdx.x;
    __shared__ float qs[64];
    __shared__ float ps[192];
    qs[lane] = qb[(size_t)lr * 512 + hh * 64 + lane];
    __syncthreads();
    int nk;
    const bool prompt = r < MP;
    int t = 0, b = 0;
    if (prompt) { t = r % SEQ; b = r / SEQ; nk = t < WINDOW ? t + 1 : WINDOW + 1; } else { b = r - MP; nk = WINDOW + 1; }
    float sc[3]; float mx = -INFINITY;
#pragma unroll
    for (int i = 0; i < 3; ++i) {
        const int j = lane + 64 * i; sc[i] = -INFINITY;
        if (j < nk) {
            const float* kp;
            if (prompt) kp = kb + ((size_t)b * SEQ + (t - nk + 1 + j)) * 128 + kvh * 64;
            else kp = j < WINDOW ? ck + ((size_t)b * WINDOW + j) * 128 + kvh * 64 : kb + (size_t)lr * 128 + kvh * 64;
            float a = 0.f;
            for (int d = 0; d < 64; ++d) a = fmaf(qs[d], kp[d], a);
            sc[i] = a; mx = fmaxf(mx, a);
        }
    }
    for (int o = 32; o > 0; o >>= 1) mx = fmaxf(mx, __shfl_xor(mx, o));
    const float sink = sinks[hh];
    mx = fmaxf(mx, sink);
    float sum = 0.f;
#pragma unroll
    for (int i = 0; i < 3; ++i) { const int j = lane + 64 * i; if (j < nk) { const float p = __expf(sc[i] - mx); ps[j] = p; sum += p; } }
    for (int o = 32; o > 0; o >>= 1) sum += __shfl_xor(sum, o);
    sum += __expf(sink - mx);
    __syncthreads();
    float acc = 0.f;
    for (int j = 0; j < nk; ++j) {
        const float* vp;
        if (prompt) vp = vb + ((size_t)b * SEQ + (t - nk + 1 + j)) * 128 + kvh * 64;
        else vp = j < WINDOW ? cv + ((size_t)b * WINDOW + j) * 128 + kvh * 64 : vb + (size_t)lr * 128 + kvh * 64;
        acc = fmaf(ps[j], vp[lane], acc);
    }
    const float z = bf2f(proj[(size_t)r * PLD + OFF_B_Z + hh * 64 + lane]);
    mix[(size_t)r * 1024 + 512 + hh * 64 + lane] = f2bf(acc / sum * siluf(z));
}

__global__ void __launch_bounds__(256) k_ln(const float* __restrict__ xp, const float* __restrict__ xs, const float* __restrict__ mod, const float* __restrict__ pre,
                                            const float* __restrict__ ln_g, const float* __restrict__ ln_b, float* __restrict__ out) {
    const int r = blockIdx.x, tid = threadIdx.x;
    const int mr = r < MP ? r / SEQ : 2 + (r - MP);
    const float* x = r < MP ? xp + (size_t)r * D_MODEL : xs + (size_t)(r - MP) * D_MODEL;
    float* y = r < MP ? out + O_YP + (size_t)r * D_MODEL : out + O_YS + (size_t)(r - MP) * D_MODEL;
    __shared__ float red[256];
    float v[4]; float s = 0.f;
#pragma unroll
    for (int i = 0; i < 4; ++i) { const int c = tid + 256 * i; v[i] = DEEPNORM_ALPHA * x[c] + (1.f + mod[(size_t)mr * 3072 + 2048 + c]) * pre[(size_t)r * D_MODEL + c]; s += v[i]; }
    red[tid] = s; __syncthreads();
    for (int o = 128; o > 0; o >>= 1) { if (tid < o) red[tid] += red[tid + o]; __syncthreads(); }
    const float mean = red[0] * (1.f / 1024.f); __syncthreads();
    float q = 0.f;
#pragma unroll
    for (int i = 0; i < 4; ++i) { v[i] -= mean; q += v[i] * v[i]; }
    red[tid] = q; __syncthreads();
    for (int o = 128; o > 0; o >>= 1) { if (tid < o) red[tid] += red[tid + o]; __syncthreads(); }
    const float rstd = rsqrtf(red[0] * (1.f / 1024.f) + LN_EPS);
#pragma unroll
    for (int i = 0; i < 4; ++i) { const int c = tid + 256 * i; y[c] = v[i] * rstd * ln_g[c] + ln_b[c]; }
}

__global__ void __launch_bounds__(NWAVES * 64, 2) mega(Args args) {
    extern __shared__ __attribute__((aligned(16))) unsigned char lds_raw[];
    Frame F;
    F.lds = (LAS unsigned char*)lds_raw;
    F.MISC = (volatile LAS unsigned*)(F.lds + MISC_OFF);
    F.tid = threadIdx.x; F.lane = F.tid & 63; F.wave = __builtin_amdgcn_readfirstlane(F.tid >> 6);
    F.G = gridDim.x; { const int bx = blockIdx.x; F.vcu = (F.G % 8 == 0) ? (bx % 8) * (F.G / 8) + bx / 8 : bx; }
    F.ws = args.ws; F.out = args.out; F.ctl = (unsigned*)(args.ws + WS_CTL);
    F.x_prompt = args.in[0]; F.x_sample = args.in[1]; F.state_conv = args.in[2]; F.state_delta = args.in[3]; F.cache_k = args.in[4]; F.cache_v = args.in[5];
    F.c_prompt = args.in[6]; F.c_sample = args.in[7]; F.w_ada = args.in[8]; F.b_ada = args.in[9]; F.w_in = args.in[10]; F.conv_w = args.in[11];
    F.a_log = args.in[12]; F.dt_bias = args.in[13]; F.norm_a = args.in[14]; F.sinks = args.in[15]; F.w_out = args.in[16]; F.ln_g = args.in[17]; F.ln_b = args.in[18];
    for (int u = F.tid; u < (LDS_BYTES - LDSCTL_OFF) / 4; u += NWAVES * 64) ((LAS unsigned*)(F.lds + LDSCTL_OFF))[u] = 0u;
    __syncthreads();
    const int lo = args.ph_lo, hi = args.ph_hi;
    XcdBarrier bar; bar.bar = F.ctl + CW_BAR; bar.x = 0; bar.st = nullptr;
    if (hi - lo > 1) bar = xcd_barrier_post(F.ctl + CW_BAR, F.MISC + 8);
#define IN(k) (lo <= (k) && (k) < hi)
#define SEAM(k) do { if (IN(k) && IN((k) + 1)) xcd_barrier(bar); } while (0)
    if (IN(0)) { p0_prologue(F); } SEAM(0);
    if (IN(1)) { p1_h(F); } SEAM(1);
    if (IN(2)) {
        pg8::Gemm g{(const pg8::bf16_t*)(F.ws + WS_H), (const pg8::bf16_t*)(F.ws + WS_WIN), MPAD, PLD, 1024}; pg8::StaticOrder S; S.init(MPAD, PLD, F.G, (int)blockIdx.x);
        pg8::EpiBf16<0> E{(pg8::bf16_t*)(F.ws + WS_PROJ), PLD, nullptr, 0, 0, 1.f};
        pg8::gemm_phase<pg8::EpiBf16<0>, pg8::StaticOrder, true, true>(F.lds, g, S, E);
    } SEAM(2);
    if (IN(3)) { for (int it = F.vcu; it < 1024; it += F.G) e1_item(F, it); } SEAM(3);
    if (IN(4)) { if (blockIdx.x < 64) scan_unit(F, (int)blockIdx.x & 7, (int)blockIdx.x >> 3);
                 else { for (int it = (int)blockIdx.x - 64; it < 256; it += F.G - 64) swa_item(F, it); } } SEAM(4);
    if (IN(5)) { for (int it = F.vcu; it < 1024; it += F.G) o_item(F, it); } SEAM(5);
    if (IN(6)) {
        pg8::Gemm g{(const pg8::bf16_t*)(F.ws + WS_H), (const pg8::bf16_t*)(F.ws + WS_WOUT), MPAD, 1024, 1024}; pg8::StaticOrder S; S.init(MPAD, 1024, F.G, (int)blockIdx.x);
        pg8::EpiF32 E{(float*)(F.ws + WS_X), 1024, nullptr};
        pg8::gemm_phase<pg8::EpiF32, pg8::StaticOrder, true, true>(F.lds, g, S, E);
    }
#undef IN
#undef SEAM
}
extern "C" void kernel_launch(void* const* d_in, const int* in_sizes, int n_in, void* d_out, int out_size, void* d_ws, size_t ws_size, hipStream_t stream) {
    static int grid = 0;
    if (grid == 0) {
        int dev = 0, cus = 0;
        if (n_in != 19 || ws_size < WS_END || hipGetDevice(&dev) != hipSuccess || hipDeviceGetAttribute(&cus, hipDeviceAttributeMultiprocessorCount, dev) != hipSuccess) { fprintf(stderr, "kernel_launch: bad environment (n_in %d ws %zu)\n", n_in, ws_size); grid = -1; return; }
        if (hipFuncSetAttribute((const void*)mega, hipFuncAttributeMaxDynamicSharedMemorySize, LDS_BYTES) != hipSuccess) { fprintf(stderr, "kernel_launch: hipFuncSetAttribute failed\n"); grid = -1; return; }
        grid = cus;
    }
    if (grid < 0) return;
    const float* x_prompt = (const float*)d_in[0]; const float* x_sample = (const float*)d_in[1];
    const float* state_conv = (const float*)d_in[2]; const float* state_delta = (const float*)d_in[3];
    const float* cache_k = (const float*)d_in[4]; const float* cache_v = (const float*)d_in[5];
    const float* conv_w = (const float*)d_in[11]; const float* a_log = (const float*)d_in[12]; const float* dt_bias = (const float*)d_in[13];
    const float* norm_a = (const float*)d_in[14]; const float* sinks = (const float*)d_in[15];
    const float* ln_g = (const float*)d_in[17]; const float* ln_b = (const float*)d_in[18];
    float* out = (float*)d_out; unsigned char* ws = (unsigned char*)d_ws;
    (void)hipMemsetAsync(ws + WS_CTL, 0, CTL_ZERO_BYTES, stream);
    Args a{};
    for (int i = 0; i < 19; ++i) a.in[i] = (const float*)d_in[i];
    a.out = out; a.ws = ws;
    auto run = [&](int lo, int hi) { a.ph_lo = lo; a.ph_hi = hi; hipLaunchKernelGGL(mega, dim3(grid), dim3(NWAVES * 64), LDS_BYTES, stream, a); };
    run(0, 1); run(1, 2); run(2, 3); run(3, 4); run(4, 5); run(5, 6);
    const bf16_t* proj = (const bf16_t*)(ws + WS_PROJ);
    bf16_t* mix = (bf16_t*)(ws + WS_H);
    const float* mod = (const float*)(ws + WS_MOD);
    float* small = (float*)(ws + 31 * MiB);
    float *qa_s = small, *ka_s = small + 128 * 512, *va_s = small + 2 * 128 * 512, *beta_s = small + 3 * 128 * 512, *g_s = beta_s + 512;
    float *qb = (float*)(ws + 27 * MiB + 65536), *kb = qb + 128 * 512, *vb = kb + 128 * 128;
    float* pre = (float*)(ws + WS_X);
    k_convA<<<dim3(DEC_BATCH, 4), 128, 0, stream>>>(proj, state_conv, conv_w, a_log, dt_bias, qa_s, ka_s, va_s, beta_s, g_s, MP);
    k_conv_state<<<(DEC_BATCH * 3 * A_QKV + 255) / 256, 256, 0, stream>>>(proj, state_conv, out);
    k_delta_rec<<<DEC_BATCH * 4, 128, 0, stream>>>(qa_s, ka_s, va_s, beta_s, g_s, state_delta, out + O_DELTAS, qa_s, 0, 1);
    k_rms_gate<<<dim3(DEC_BATCH, 4), 128, 0, stream>>>(qa_s, proj, norm_a, mix, MP);
    k_rope<<<DEC_BATCH, 128, 0, stream>>>(proj, qb, kb, vb, MP);
    k_cache_out<<<(DEC_BATCH * WINDOW * 128 + 255) / 256, 256, 0, stream>>>(kb, vb, cache_k, cache_v, out);
    k_swa<<<dim3(DEC_BATCH, 8), 64, 0, stream>>>(qb, kb, vb, cache_k, cache_v, sinks, proj, mix, MP);
    run(6, 7);
    k_ln<<<MT, 256, 0, stream>>>(x_prompt, x_sample, mod, pre, ln_g, ln_b, out);
}
```

```cpp
#include <hip/hip_runtime.h>
#include <cstdio>
#include <cstdint>
#include <cstddef>

constexpr int D_MODEL = 1024, BATCH = 2, SEQ = 8192, DEC_BATCH = 128, PAST_LEN = 8192;
constexpr int A_HEADS = 4, A_DK = 128, A_DV = 128, A_WIDTH = 512, A_QKV = 1536, CONV_W = 4;
constexpr int B_HEADS = 8, B_KV_HEADS = 2, B_HD = 64, B_GROUP = 4, B_WIDTH = 512, B_KV_WIDTH = 128, WINDOW = 128;
constexpr int OFF_A_QKV = 0, OFF_A_Z = 1536, OFF_A_BETA = 2048, OFF_A_DECAY = 2052, OFF_B_Q = 2056, OFF_B_K = 2568, OFF_B_V = 2696, OFF_B_Z = 2824, PROJ_COLS = 3336;
constexpr int MP = BATCH * SEQ;
constexpr int MT = MP + DEC_BATCH;
constexpr int MPAD = 16640;
constexpr int PLD = 3584;
constexpr float LN_EPS = 1e-5f, RMS_EPS = 1e-6f, L2_EPS = 1e-6f;
constexpr float DEEPNORM_ALPHA = 1.189207115002721f;

constexpr size_t O_YP = 0;
constexpr size_t O_YS = O_YP + (size_t)MP * D_MODEL;
constexpr size_t O_CONVP = O_YS + (size_t)DEC_BATCH * D_MODEL;
constexpr size_t O_DELTAP = O_CONVP + (size_t)BATCH * 3 * A_QKV;
constexpr size_t O_KP = O_DELTAP + (size_t)BATCH * A_HEADS * A_DK * A_DV;
constexpr size_t O_VP = O_KP + (size_t)BATCH * WINDOW * B_KV_WIDTH;
constexpr size_t O_CONVS = O_VP + (size_t)BATCH * WINDOW * B_KV_WIDTH;
constexpr size_t O_DELTAS = O_CONVS + (size_t)DEC_BATCH * 3 * A_QKV;
constexpr size_t O_KS = O_DELTAS + (size_t)DEC_BATCH * A_HEADS * A_DK * A_DV;
constexpr size_t O_VS = O_KS + (size_t)DEC_BATCH * WINDOW * B_KV_WIDTH;
constexpr size_t O_END = O_VS + (size_t)DEC_BATCH * WINDOW * B_KV_WIDTH;

constexpr size_t MiB = 1u << 20;
constexpr size_t WS_CTL = 0, CTL_ZERO_BYTES = 1 * MiB;
constexpr size_t WS_WIN = 2 * MiB;
constexpr size_t WS_WOUT = 10 * MiB;
constexpr size_t WS_MOD = 12 * MiB;
constexpr size_t WS_SLAB = 14 * MiB;
constexpr size_t WS_ROPE = 28 * MiB;
constexpr size_t WS_H = 32 * MiB;
constexpr size_t WS_PROJ = 66 * MiB;
constexpr size_t WS_X = 180 * MiB;
constexpr size_t WS_END = 256 * MiB;
constexpr int CW_BAR = 4096;

typedef unsigned short bf16_t;
typedef float f32x4 __attribute__((ext_vector_type(4)));
typedef unsigned u32x4 __attribute__((ext_vector_type(4)));
typedef unsigned u32x2 __attribute__((ext_vector_type(2)));
typedef short bf16x8 __attribute__((ext_vector_type(8)));
__device__ __forceinline__ float bf2f(bf16_t v) { return __uint_as_float(((unsigned)v) << 16); }
__device__ __forceinline__ bf16_t f2bf(float f) { unsigned u = __float_as_uint(f); return (bf16_t)((u + 0x7fffu + ((u >> 16) & 1u)) >> 16); }
__device__ __forceinline__ unsigned pk2(float lo, float hi) { return (unsigned)f2bf(lo) | ((unsigned)f2bf(hi) << 16); }
__device__ __forceinline__ void stc(float* p, float v) { *p = v; }
__device__ __forceinline__ void stc(bf16_t* p, float v) { *p = f2bf(v); }
__device__ __forceinline__ float siluf(float x) { return x / (1.f + __expf(-x)); }
__device__ __forceinline__ float sigmoidf_(float x) { return 1.f / (1.f + __expf(-x)); }
__device__ __forceinline__ float softplusf_(float x) { return x > 20.f ? x : log1pf(__expf(x)); }
__device__ __forceinline__ void rope_cs(int pos, int i, float& c, float& s) {
    const float inv = 1.0f / powf(10000.0f, (float)i / 32.0f);
    const float ang = (float)pos * inv;
    const double a = (double)ang;
    const double k = rint(a * 0.15915494309189535);
    const double rr = a - k * 6.283185307179586;
    c = (float)cos(rr); s = (float)sin(rr);
}
namespace pg8 {
#define PG8_LAS __attribute__((address_space(3)))
typedef unsigned short bf16_t;
typedef short bf16x8 __attribute__((ext_vector_type(8)));
typedef float f32x4 __attribute__((ext_vector_type(4)));
typedef unsigned u32x4 __attribute__((ext_vector_type(4)));
constexpr int BM = 256, BK = 64, HALF = 128, HTB = HALF * BK * 2  , STAGE_BYTES = 8 * HTB, NXCD = 8, WGM = 8;

__host__ __device__ __forceinline__ int lds_byte(int r, int c) { const int st = (r >> 4) * 2 + (c >> 5), rr = r & 15, cc = c & 31, ob = rr * 64 + cc * 2; return st * 1024 + (ob ^ (((ob >> 9) & 1) << 5)); }
__host__ __device__ __forceinline__ void stage_rc(int b, int& R, int& C) { const int st = b / 1024, sb = b % 1024, swz = sb ^ (((sb >> 9) & 1) << 5); R = (st >> 1) * 16 + swz / 64; C = (st & 1) * 32 + (swz % 64) / 2; }
__host__ __device__ __forceinline__ int perm32(int rho) { const int n = rho >> 4, i = rho & 15; return 8 * (i >> 2) + 4 * n + (i & 3); }

struct Unit { int pm, pn; };
struct Gemm { const bf16_t* A; const bf16_t* Bt; int M, N, K; };

struct StaticOrder {
    int nM, nN, nwg, G, c;
    __host__ __device__ void init(int M, int N, int G_, int c_) { nM = M / BM; nN = N / BM; nwg = nM * nN; G = G_; c = c_; }
    __host__ __device__ bool next(int i, Unit& u) const {
        const long L = (long)i * G + c; if (L >= nwg) return false;
        int wgid = (int)L; { const int q = nwg / NXCD, r = nwg % NXCD, xcd = wgid % NXCD, off = wgid / NXCD; wgid = (xcd < r ? xcd * (q + 1) : r * (q + 1) + (xcd - r) * q) + off; }
        const int nig = WGM * nN, gid = wgid / nig, fm = gid * WGM, gsz = (nM - fm) < WGM ? (nM - fm) : WGM;
        u.pm = fm + ((wgid % nig) % gsz); u.pn = (wgid % nig) / gsz; return true;
    }
    __device__ __forceinline__ void a_ready(const Unit&) const {}
    __device__ __forceinline__ void done(const Unit&) const {}
};

__device__ __forceinline__ unsigned cvt_pk_bf16(float lo, float hi) { unsigned r; asm volatile("v_cvt_pk_bf16_f32 %0, %1, %2" : "=v"(r) : "v"(lo), "v"(hi)); return r; }
typedef float f32x2 __attribute__((ext_vector_type(2)));
__device__ __forceinline__ f32x2 gelu_pk(f32x2 v) {
    const f32x2 av = __builtin_elementwise_abs(v), d = av * 0.2316418882f + 1.0f;
    f32x2 t; t.x = __builtin_amdgcn_rcpf(d.x); t.y = __builtin_amdgcn_rcpf(d.y);
    f32x2 q = t * 0.5307027145f + (-0.7265760135f); q = q * t + 0.7107068705f; q = q * t + (-0.142248368f); q = q * t + 0.127414796f; q = q * t;
    const f32x2 s = (v * v) * (-0.72134752044f);
    f32x2 e; e.x = __builtin_amdgcn_exp2f(s.x); e.y = __builtin_amdgcn_exp2f(s.y);
    const f32x2 m = v * (q * e), r = v - m;
    f32x2 o; o.x = v.x < 0.f ? m.x : r.x; o.y = v.y < 0.f ? m.y : r.y; return o;
}

struct EpiF32 {
    static constexpr bool PERM = false, AFTER_DRAIN = false;
    float* C; int ldc; const float* bias;
    __device__ __forceinline__ void operator()(const f32x4 (&acc)[2][2][4][2], const Unit& u, int wr, int wc, int fr, int fq) const {
        const int row0 = u.pm * BM + wr * 64 + fr, col0 = u.pn * BM + wc * 32 + 4 * fq;
        f32x4 bv[2][2];
#pragma unroll
        for (int bj = 0; bj < 2; ++bj)
#pragma unroll
            for (int n = 0; n < 2; ++n) bv[bj][n] = bias ? *(const f32x4*)(bias + col0 + bj * HALF + n * 16) : (f32x4){0.f, 0.f, 0.f, 0.f};
#pragma unroll
        for (int ai = 0; ai < 2; ++ai)
#pragma unroll
            for (int m = 0; m < 4; ++m) { float* rowp = C + (size_t)(row0 + ai * HALF + m * 16) * ldc + col0;
#pragma unroll
                for (int bj = 0; bj < 2; ++bj)
#pragma unroll
                    for (int n = 0; n < 2; ++n) *(f32x4*)(rowp + bj * HALF + n * 16) = acc[ai][bj][m][n] + bv[bj][n]; }
    }
};
template <int ACT  > struct EpiBf16 {
    static constexpr bool PERM = true, AFTER_DRAIN = false; static_assert(ACT == 0 || ACT == 1, "EpiBf16: ACT is 0 (none) or 1 (gelu_pk)");
    bf16_t* O; int ldc; const float* bias; int split_cols; size_t split_stride; float scale0;
    __device__ __forceinline__ void operator()(const f32x4 (&acc)[2][2][4][2], const Unit& u, int wr, int wc, int fr, int fq) const {
        const int row0 = u.pm * BM + wr * 64 + fr; int colt = u.pn * BM; bf16_t* base = O;
        float sc = 1.f; if (split_cols) { const int t = colt / split_cols; base += (size_t)t * split_stride; colt -= t * split_cols; if (t == 0) sc = scale0; }
        const int col0 = colt + wc * 32 + 8 * fq, bcol0 = u.pn * BM + wc * 32 + 8 * fq;
        f32x4 bv[2][2];
#pragma unroll
        for (int bj = 0; bj < 2; ++bj)
#pragma unroll
            for (int n = 0; n < 2; ++n) bv[bj][n] = bias ? *(const f32x4*)(bias + bcol0 + bj * HALF + 4 * n) : (f32x4){0.f, 0.f, 0.f, 0.f};
#pragma unroll
        for (int ai = 0; ai < 2; ++ai)
#pragma unroll
            for (int m = 0; m < 4; ++m) { bf16_t* rowp = base + (size_t)(row0 + ai * HALF + m * 16) * ldc + col0;
#pragma unroll
                for (int bj = 0; bj < 2; ++bj) { f32x4 v0 = acc[ai][bj][m][0] + bv[bj][0], v1 = acc[ai][bj][m][1] + bv[bj][1];
                    if (ACT == 1) { f32x2 a = gelu_pk((f32x2){v0[0], v0[1]}), b = gelu_pk((f32x2){v0[2], v0[3]}), c = gelu_pk((f32x2){v1[0], v1[1]}), d = gelu_pk((f32x2){v1[2], v1[3]});
                        v0 = (f32x4){a.x, a.y, b.x, b.y}; v1 = (f32x4){c.x, c.y, d.x, d.y}; }
                    v0 = v0 * sc; v1 = v1 * sc; u32x4 w; w.x = cvt_pk_bf16(v0[0], v0[1]); w.y = cvt_pk_bf16(v0[2], v0[3]); w.z = cvt_pk_bf16(v1[0], v1[1]); w.w = cvt_pk_bf16(v1[2], v1[3]);
                    *(u32x4*)(rowp + bj * HALF) = w; } }
    }
};

struct PanelStats {
    unsigned* xbuf;
    unsigned* cnt;
    unsigned* tmo;
    int ntn; float eps;
    unsigned code;
    __device__ __forceinline__ bool run(const f32x4 (&v)[2][2][4][2], const Unit& u, int wr, int wc, int fr, int fq, PG8_LAS unsigned char* lds, int wid, int lane) const {
        typedef float f32x2v __attribute__((ext_vector_type(2)));
        PG8_LAS f32x2v* P = (PG8_LAS f32x2v*)lds;
        PG8_LAS f32x2v* S = (PG8_LAS f32x2v*)(lds + 8192);
        PG8_LAS unsigned* flag = (PG8_LAS unsigned*)(lds + 8192 + 2048);
#pragma unroll
        for (int ai = 0; ai < 2; ++ai)
#pragma unroll
            for (int m = 0; m < 4; ++m) {
                float s = 0.f;
#pragma unroll
                for (int bj = 0; bj < 2; ++bj)
#pragma unroll
                    for (int n = 0; n < 2; ++n) { const f32x4 x = v[ai][bj][m][n]; s += (x[0] + x[1]) + (x[2] + x[3]); }
                s += __shfl_xor(s, 16); s += __shfl_xor(s, 32);
                const float mw = s * (1.0f / 64.0f); float q = 0.f;
#pragma unroll
                for (int bj = 0; bj < 2; ++bj)
#pragma unroll
                    for (int n = 0; n < 2; ++n) { const f32x4 d = v[ai][bj][m][n] - mw; q += (d[0] * d[0] + d[1] * d[1]) + (d[2] * d[2] + d[3] * d[3]); }
                q += __shfl_xor(q, 16); q += __shfl_xor(q, 32);
                if (fq == 0) P[(ai * HALF + wr * 64 + m * 16 + fr) * 4 + wc] = (f32x2v){mw, q};
            }
        asm volatile("s_waitcnt lgkmcnt(0)" ::: "memory"); __builtin_amdgcn_s_barrier(); asm volatile("" ::: "memory");
#if defined(BROKEN_EXCHANGE_NO_WAIT)
#warning BROKEN CONTROL BUILD: the row-statistics exchange does not wait; results are wrong by design
        if (blockIdx.x >= 64) { const long long t0_ = clock64(); while (clock64() - t0_ < 60000) __builtin_amdgcn_s_sleep(8); }
#endif
        const int row = wid * 32 + (lane & 31);
        if (lane < 32) {
            const f32x2v a = P[row * 4 + 0], b = P[row * 4 + 1], c = P[row * 4 + 2], d = P[row * 4 + 3];
            const float mt = (a.x + b.x + c.x + d.x) * 0.25f;
            const float da = a.x - mt, db = b.x - mt, dc = c.x - mt, dd = d.x - mt;
            const float m2 = (a.y + b.y) + (c.y + d.y) + 64.0f * ((da * da + db * db) + (dc * dc + dd * dd));
            unsigned long long* slot = (unsigned long long*)xbuf + ((size_t)(u.pm * BM + row) * 4 + u.pn);
            __hip_atomic_store(slot, ((unsigned long long)__float_as_uint(m2) << 32) | __float_as_uint(mt), __ATOMIC_RELAXED, __HIP_MEMORY_SCOPE_AGENT);
        }
        asm volatile("s_waitcnt vmcnt(0)" ::: "memory");
        if (lane == 0) __hip_atomic_fetch_add(cnt + 64 * u.pm, 1u, __ATOMIC_RELAXED, __HIP_MEMORY_SCOPE_AGENT);
        if (wid == 0) {
            bool dead = false; const unsigned long long t0 = __builtin_amdgcn_s_memrealtime(); const unsigned want = 8u * (unsigned)ntn;
            for (;;) {
#if defined(BROKEN_EXCHANGE_NO_WAIT)
                break;
#endif
                if ((unsigned)__builtin_amdgcn_readfirstlane(__hip_atomic_load(cnt + 64 * u.pm, __ATOMIC_RELAXED, __HIP_MEMORY_SCOPE_AGENT)) >= want) break;
                if (__builtin_amdgcn_s_memrealtime() - t0 > 2000000ull) {
                    if (lane == 0) { unsigned expect = 0u; __hip_atomic_compare_exchange_strong(tmo + 1, &expect, code | (unsigned)(u.pm & 0xff), __ATOMIC_RELAXED, __ATOMIC_RELAXED, __HIP_MEMORY_SCOPE_AGENT);
                                     __hip_atomic_store(tmo, 1u, __ATOMIC_RELAXED, __HIP_MEMORY_SCOPE_AGENT); }
                    dead = true; break; }
                __builtin_amdgcn_s_sleep(2);
            }
            __builtin_amdgcn_fence(__ATOMIC_ACQUIRE, "agent");
            if (lane == 0) flag[0] = dead ? 1u : 0u;
        }
        asm volatile("s_waitcnt vmcnt(0) lgkmcnt(0)" ::: "memory"); __builtin_amdgcn_s_barrier(); asm volatile("" ::: "memory");
        const bool bad = flag[0] != 0u;
        if (lane < 32) {
            const unsigned long long* slot = (const unsigned long long*)xbuf + (size_t)(u.pm * BM + row) * 4; float mt[4], m2[4]; float ms = 0.f;
#pragma unroll
            for (int t = 0; t < 4; ++t) { if (t < ntn) { const unsigned long long w = __hip_atomic_load(slot + t, __ATOMIC_RELAXED, __HIP_MEMORY_SCOPE_AGENT); mt[t] = __uint_as_float((unsigned)w); m2[t] = __uint_as_float((unsigned)(w >> 32)); } else { mt[t] = 0.f; m2[t] = 0.f; } ms += mt[t]; }
            const float mean = ms / (float)ntn; float q = 0.f;
#pragma unroll
            for (int t = 0; t < 4; ++t) if (t < ntn) { const float dm = mt[t] - mean; q += m2[t] + 256.0f * dm * dm; }
            S[row] = (f32x2v){mean, 1.0f / sqrtf(q / (256.0f * (float)ntn) + eps)};
        }
        asm volatile("s_waitcnt lgkmcnt(0)" ::: "memory"); __builtin_amdgcn_s_barrier(); asm volatile("" ::: "memory");
        return bad;
    }
};
struct EpiLnRes {
    static constexpr bool PERM = false, AFTER_DRAIN = true;
    const float* base; float* out; int ldc; const float* bias; PanelStats st; unsigned poison;
    __device__ __forceinline__ void fused(f32x4 (&acc)[2][2][4][2], const Unit& u, int wr, int wc, int fr, int fq, PG8_LAS unsigned char* lds, int wid, int lane) const {
        typedef float f32x2v __attribute__((ext_vector_type(2)));
        const PG8_LAS f32x2v* S = (const PG8_LAS f32x2v*)(lds + 8192);
        const int col0 = u.pn * BM + wc * 32 + 4 * fq;
#pragma unroll
        for (int bj = 0; bj < 2; ++bj)
#pragma unroll
            for (int n = 0; n < 2; ++n) { const f32x4 bv = bias ? *(const f32x4*)(bias + col0 + bj * HALF + n * 16) : (f32x4){0.f, 0.f, 0.f, 0.f};
#pragma unroll
                for (int ai = 0; ai < 2; ++ai)
#pragma unroll
                    for (int m = 0; m < 4; ++m) acc[ai][bj][m][n] += bv; }
        f32x4 pre[4][2][2];
#pragma unroll
        for (int m = 0; m < 4; ++m) { const size_t off = (size_t)(u.pm * BM + wr * 64 + m * 16 + fr) * ldc + col0;
#pragma unroll
            for (int bj = 0; bj < 2; ++bj)
#pragma unroll
                for (int n = 0; n < 2; ++n) pre[m][bj][n] = *(const f32x4*)(base + off + bj * HALF + n * 16); }
        const bool bad = st.run(acc, u, wr, wc, fr, fq, lds, wid, lane) || poison != 0u;
        const float qnan = __builtin_nanf("");
#pragma unroll
        for (int ai = 0; ai < 2; ++ai)
#pragma unroll
            for (int m = 0; m < 4; ++m) { const int r = ai * HALF + wr * 64 + m * 16 + fr; const f32x2v sr = S[r]; const size_t off = (size_t)(u.pm * BM + r) * ldc + col0;
#pragma unroll
                for (int bj = 0; bj < 2; ++bj)
#pragma unroll
                    for (int n = 0; n < 2; ++n) { const f32x4 bs = ai == 0 ? pre[m][bj][n] : *(const f32x4*)(base + off + bj * HALF + n * 16); f32x4 o = bs + (acc[ai][bj][m][n] - sr.x) * sr.y;
                        if (bad) o = (f32x4){qnan, qnan, qnan, qnan}; *(f32x4*)(out + off + bj * HALF + n * 16) = o; }
                if (m & 1) asm volatile("" ::: "memory"); }
    }
};
struct EpiLnResLn {
    static constexpr bool PERM = false, AFTER_DRAIN = true;
    const float* base; float* out; bf16_t* xn; int ldc; const float* bias; PanelStats st1, st2; unsigned poison;
    __device__ __forceinline__ void fused(f32x4 (&acc)[2][2][4][2], const Unit& u, int wr, int wc, int fr, int fq, PG8_LAS unsigned char* lds, int wid, int lane) const {
        typedef float f32x2v __attribute__((ext_vector_type(2))); typedef unsigned u32x2v __attribute__((ext_vector_type(2)));
        const PG8_LAS f32x2v* S = (const PG8_LAS f32x2v*)(lds + 8192);
        const int col0 = u.pn * BM + wc * 32 + 4 * fq;
#pragma unroll
        for (int bj = 0; bj < 2; ++bj)
#pragma unroll
            for (int n = 0; n < 2; ++n) { const f32x4 bv = bias ? *(const f32x4*)(bias + col0 + bj * HALF + n * 16) : (f32x4){0.f, 0.f, 0.f, 0.f};
#pragma unroll
                for (int ai = 0; ai < 2; ++ai)
#pragma unroll
                    for (int m = 0; m < 4; ++m) acc[ai][bj][m][n] += bv; }
        bool bad = st1.run(acc, u, wr, wc, fr, fq, lds, wid, lane) || poison != 0u;
        const float qnan = __builtin_nanf("");
#pragma unroll
        for (int ai = 0; ai < 2; ++ai)
#pragma unroll
            for (int m = 0; m < 4; ++m) { const int r = ai * HALF + wr * 64 + m * 16 + fr; const f32x2v sr = S[r]; const size_t off = (size_t)(u.pm * BM + r) * ldc + col0;
#pragma unroll
                for (int bj = 0; bj < 2; ++bj)
#pragma unroll
                    for (int n = 0; n < 2; ++n) { const f32x4 bs = *(const f32x4*)(base + off + bj * HALF + n * 16); acc[ai][bj][m][n] = bs + (acc[ai][bj][m][n] - sr.x) * sr.y; }
                asm volatile("" : "+v"(acc[ai][0][m][0]), "+v"(acc[ai][0][m][1]), "+v"(acc[ai][1][m][0]), "+v"(acc[ai][1][m][1]));
                if (m & 1) asm volatile("" ::: "memory"); }
        const bool bad1 = bad;
        bad = st2.run(acc, u, wr, wc, fr, fq, lds, wid, lane) || bad;
#pragma unroll
        for (int ai = 0; ai < 2; ++ai)
#pragma unroll
            for (int m = 0; m < 4; ++m) { const int r = ai * HALF + wr * 64 + m * 16 + fr; const f32x2v sr = S[r]; const size_t off = (size_t)(u.pm * BM + r) * ldc + col0;
#pragma unroll
                for (int bj = 0; bj < 2; ++bj)
#pragma unroll
                    for (int n = 0; n < 2; ++n) { const f32x4 x1 = acc[ai][bj][m][n]; *(f32x4*)(out + off + bj * HALF + n * 16) = bad1 ? (f32x4){qnan, qnan, qnan, qnan} : x1;
                        const f32x4 o = (x1 - sr.x) * sr.y; u32x2v w; w.x = cvt_pk_bf16(o[0], o[1]); w.y = cvt_pk_bf16(o[2], o[3]);
                        if (bad) { w.x = 0x7fc07fc0u; w.y = 0x7fc07fc0u; } *(u32x2v*)(xn + off + bj * HALF + n * 16) = w; }
                asm volatile("" ::: "memory"); }
    }
};

template <class Epi, class Sched, bool ALIGN_EPI = false, bool SP2 = false>
__device__ __forceinline__ void gemm_phase(PG8_LAS unsigned char* lds, const Gemm g, const Sched& S, const Epi& E) {
    const int tid = threadIdx.x, wid = __builtin_amdgcn_readfirstlane(tid >> 6), lane = tid & 63, wr = wid >> 2, wc = wid & 3, fr = lane & 15, fq = lane >> 4;
    const int K = g.K, nt = K / BK;
    unsigned voffA[2], voffB[2];
#pragma unroll
    for (int i = 0; i < 2; ++i) { int R, C; stage_rc(tid * 16 + i * 8192, R, C); const int Rb = Epi::PERM ? ((R & ~31) + perm32(R & 31)) : R;
        voffA[i] = (unsigned)(R * K + C) * 2u; voffB[i] = (unsigned)(Rb * K + C) * 2u; }
    const size_t kstep = (size_t)(BK * 2);
    const size_t hstep = (size_t)HALF * K * 2;
    const size_t tstep = 2 * hstep;
    const unsigned ldsw = (unsigned)wid * 1024u;
    const int aoff = lds_byte(wr * 64 + fr, fq * 8), boff = lds_byte(wc * 32 + fr, fq * 8);
#define PG8_SA(b, h) (((b) * 2 + (h)) * HTB)
#define PG8_SB(b, h) ((4 + (b) * 2 + (h)) * HTB)
#define PG8_STAGE(bufoff, gbase, voff) do { _Pragma("unroll") for (int _i = 0; _i < 2; ++_i) \
        __builtin_amdgcn_global_load_lds((const unsigned*)((const char*)(gbase) + (voff)[_i]), (PG8_LAS unsigned*)(lds + (bufoff) + ldsw + _i * 8192), 16, 0, 0); } while (0)
#define PG8_LDA(dst, b, h) do { _Pragma("unroll") for (int m = 0; m < 4; ++m) _Pragma("unroll") for (int k = 0; k < 2; ++k) dst[m][k] = *(const PG8_LAS bf16x8*)(lds + PG8_SA(b, h) + aoff + m * 2048 + k * 1024); } while (0)
#define PG8_LDB(dst, b, h) do { _Pragma("unroll") for (int n = 0; n < 2; ++n) _Pragma("unroll") for (int k = 0; k < 2; ++k) dst[n][k] = *(const PG8_LAS bf16x8*)(lds + PG8_SB(b, h) + boff + n * 2048 + k * 1024); } while (0)
#define PG8_MMA(ai, bj, At, Bt) do { __builtin_amdgcn_s_setprio(1); _Pragma("unroll") for (int m = 0; m < 4; ++m) _Pragma("unroll") for (int n = 0; n < 2; ++n) _Pragma("unroll") for (int k = 0; k < 2; ++k) \
        acc[ai][bj][m][n] = __builtin_amdgcn_mfma_f32_16x16x32_bf16(Bt[n][k], At[m][k], acc[ai][bj][m][n], 0, 0, 0); __builtin_amdgcn_s_setprio(0); } while (0)
#define PG8_WAIT_V(n) asm volatile("s_waitcnt vmcnt(" #n ")" ::: "memory")
#define PG8_WAIT_L(n) asm volatile("s_waitcnt lgkmcnt(" #n ")" ::: "memory")
#define PG8_BAR __builtin_amdgcn_s_barrier()
#define PG8_SCHED __builtin_amdgcn_sched_barrier(0)
    Unit cur, nxt; int ui = 0;
    if (!S.next(0, cur)) return;
    f32x4 acc[2][2][4][2];
#pragma unroll
    for (int a = 0; a < 2; ++a)
#pragma unroll
        for (int b = 0; b < 2; ++b)
#pragma unroll
            for (int m = 0; m < 4; ++m)
#pragma unroll
                for (int n = 0; n < 2; ++n) acc[a][b][m][n] = (f32x4){0.f, 0.f, 0.f, 0.f};
    bf16x8 At[4][2], B0[2][2], B1[2][2];
    const char* cA = (const char*)g.A + (size_t)cur.pm * tstep; const char* cB = (const char*)g.Bt + (size_t)cur.pn * tstep;
    S.a_ready(cur);
    if constexpr (SP2) {
        PG8_STAGE(PG8_SB(0, 0), cB, voffB); PG8_STAGE(PG8_SB(0, 1), cB + hstep, voffB); PG8_STAGE(PG8_SA(0, 0), cA, voffA); PG8_STAGE(PG8_SA(0, 1), cA + hstep, voffA);
        if (wr == 1) PG8_BAR;
        PG8_WAIT_V(2); PG8_BAR;
        PG8_STAGE(PG8_SB(1, 0), cB + kstep, voffB); PG8_STAGE(PG8_SA(1, 0), cA + kstep, voffA); PG8_STAGE(PG8_SB(1, 1), cB + hstep + kstep, voffB);
        PG8_WAIT_V(6); PG8_BAR;
    } else {
        PG8_STAGE(PG8_SB(0, 0), cB, voffB); PG8_STAGE(PG8_SA(0, 0), cA, voffA); PG8_STAGE(PG8_SB(0, 1), cB + hstep, voffB); PG8_STAGE(PG8_SA(0, 1), cA + hstep, voffA);
        if (wr == 1) PG8_BAR;
        PG8_WAIT_V(4); PG8_BAR;
        PG8_STAGE(PG8_SB(1, 0), cB + kstep, voffB); PG8_STAGE(PG8_SA(1, 0), cA + kstep, voffA); PG8_STAGE(PG8_SB(1, 1), cB + hstep + kstep, voffB);
        PG8_WAIT_V(6); PG8_BAR;
    }
    for (;;) {
        const bool has_next = S.next(ui + 1, nxt);
        const char* nA = has_next ? (const char*)g.A + (size_t)nxt.pm * tstep : cA; const char* nB = has_next ? (const char*)g.Bt + (size_t)nxt.pn * tstep : cB;
        for (int t = 0; t < nt; t += 2) {
            const bool last = (t == nt - 2);
            const char* a1 = cA + (size_t)(t + 1) * kstep;
            const char* a2 = last ? nA : cA + (size_t)(t + 2) * kstep; const char* b2 = last ? nB : cB + (size_t)(t + 2) * kstep;
            const char* a3 = a2 + kstep; const char* b3 = b2 + kstep;
            if (last && has_next) S.a_ready(nxt);
            if constexpr (SP2) {
            PG8_LDB(B0, 0, 0); PG8_LDB(B1, 0, 1); PG8_SCHED; PG8_LDA(At, 0, 0); PG8_STAGE(PG8_SA(1, 1), a1 + hstep, voffA);
            PG8_WAIT_V(8); PG8_WAIT_L(0); PG8_BAR; PG8_MMA(0, 0, At, B0); PG8_MMA(0, 1, At, B1); PG8_BAR; PG8_SCHED;
            PG8_LDA(At, 0, 1); PG8_STAGE(PG8_SB(0, 0), b2, voffB); PG8_STAGE(PG8_SB(0, 1), b2 + hstep, voffB); PG8_STAGE(PG8_SA(0, 0), a2, voffA);
            PG8_WAIT_V(8); PG8_WAIT_L(0); PG8_BAR; PG8_MMA(1, 0, At, B0); PG8_MMA(1, 1, At, B1); PG8_BAR; PG8_SCHED;
            PG8_LDB(B0, 1, 0); PG8_LDB(B1, 1, 1); PG8_SCHED; PG8_LDA(At, 1, 0); PG8_STAGE(PG8_SA(0, 1), a2 + hstep, voffA);
            PG8_WAIT_V(8); PG8_WAIT_L(0); PG8_BAR; PG8_MMA(0, 0, At, B0); PG8_MMA(0, 1, At, B1); PG8_BAR; PG8_SCHED;
            PG8_LDA(At, 1, 1); PG8_STAGE(PG8_SB(1, 0), b3, voffB); PG8_STAGE(PG8_SB(1, 1), b3 + hstep, voffB); PG8_STAGE(PG8_SA(1, 0), a3, voffA);
            PG8_WAIT_V(8); PG8_WAIT_L(0); PG8_BAR; PG8_MMA(1, 0, At, B0); PG8_MMA(1, 1, At, B1); PG8_BAR; PG8_SCHED;
            } else {
            PG8_LDB(B0, 0, 0); PG8_SCHED; PG8_LDA(At, 0, 0); PG8_STAGE(PG8_SA(1, 1), a1 + hstep, voffA);
            PG8_WAIT_L(8); PG8_BAR; PG8_WAIT_L(0); PG8_MMA(0, 0, At, B0); PG8_BAR; PG8_SCHED;
            PG8_LDB(B1, 0, 1); PG8_STAGE(PG8_SB(0, 0), b2, voffB);
            PG8_BAR; PG8_WAIT_L(0); PG8_MMA(0, 1, At, B1); PG8_BAR;
            PG8_LDA(At, 0, 1); PG8_STAGE(PG8_SA(0, 0), a2, voffA);
            PG8_BAR; PG8_WAIT_L(0); PG8_MMA(1, 0, At, B0); PG8_BAR; PG8_SCHED;
            PG8_STAGE(PG8_SB(0, 1), b2 + hstep, voffB);
            PG8_WAIT_V(6); PG8_BAR; PG8_MMA(1, 1, At, B1); PG8_BAR;
            PG8_LDB(B0, 1, 0); PG8_SCHED; PG8_LDA(At, 1, 0); PG8_STAGE(PG8_SA(0, 1), a2 + hstep, voffA);
            PG8_WAIT_L(8); PG8_BAR; PG8_WAIT_L(0); PG8_MMA(0, 0, At, B0); PG8_BAR; PG8_SCHED;
            PG8_LDB(B1, 1, 1); PG8_STAGE(PG8_SB(1, 0), b3, voffB);
            PG8_BAR; PG8_WAIT_L(0); PG8_MMA(0, 1, At, B1); PG8_BAR;
            PG8_LDA(At, 1, 1); PG8_STAGE(PG8_SA(1, 0), a3, voffA);
            PG8_BAR; PG8_WAIT_L(0); PG8_MMA(1, 0, At, B0); PG8_BAR; PG8_SCHED;
            PG8_STAGE(PG8_SB(1, 1), b3 + hstep, voffB);
            PG8_WAIT_V(6); PG8_BAR; PG8_MMA(1, 1, At, B1); PG8_BAR;
            }
        }
        if constexpr (ALIGN_EPI) { if (wr == 0) PG8_BAR; }
        if constexpr (!Epi::AFTER_DRAIN) { E(acc, cur, wr, wc, fr, fq); S.done(cur); }
        if (!has_next) break;
#pragma unroll
        for (int a = 0; a < 2; ++a)
#pragma unroll
            for (int b = 0; b < 2; ++b)
#pragma unroll
                for (int m = 0; m < 4; ++m)
#pragma unroll
                    for (int n = 0; n < 2; ++n) acc[a][b][m][n] = (f32x4){0.f, 0.f, 0.f, 0.f};
        cur = nxt; cA = nA; cB = nB; ++ui;
        if constexpr (ALIGN_EPI) { if (wr == 1) PG8_BAR; }
    }
    PG8_WAIT_V(0);
    if constexpr (!ALIGN_EPI) { if (wr == 0) PG8_BAR; }
    PG8_BAR;
    if constexpr (Epi::AFTER_DRAIN) { E.fused(acc, cur, wr, wc, fr, fq, lds, wid, lane); S.done(cur); }
#undef PG8_SA
#undef PG8_SB
#undef PG8_STAGE
#undef PG8_LDA
#undef PG8_LDB
#undef PG8_MMA
#undef PG8_WAIT_V
#undef PG8_WAIT_L
#undef PG8_BAR
#undef PG8_SCHED
}
}
#define GAS __attribute__((address_space(1)))
#define LAS __attribute__((address_space(3)))
typedef GAS unsigned gu32;
#define LDS_WAIT() asm volatile("s_waitcnt lgkmcnt(0)" ::: "memory")
#define VM_WAIT() asm volatile("s_waitcnt vmcnt(0)" ::: "memory")
#define XB_TMO      128
#define XB_XCNT(j)  (256  + 64 * (j))
#define XB_XSUB(j)  (1280 + 64 * (j))
#define XB_XGEN(j)  (2304 + 64 * (j))
#define XB_TOP      3328
#define XB_TOPGEN   3392
#define XCD_BAR_WORDS 3456
#define XB_SPIN_CAP (1u << 18)

__device__ __forceinline__ unsigned xb_ld(unsigned* p)              { return __hip_atomic_load(p, __ATOMIC_RELAXED, __HIP_MEMORY_SCOPE_AGENT); }
__device__ __forceinline__ unsigned xb_add(unsigned* p, unsigned v) { return __hip_atomic_fetch_add(p, v, __ATOMIC_RELAXED, __HIP_MEMORY_SCOPE_AGENT); }
__device__ __forceinline__ unsigned xb_xcc_id() { return (unsigned)__builtin_amdgcn_s_getreg((3 << 11) | 20) & 0xFu; }
#define XB_SPIN(cond, bar) do { unsigned _sp = 0; while (cond) { __builtin_amdgcn_s_sleep(1); \
    if ((++_sp & 255u) == 0u) { if (xb_ld(&(bar)[XB_TMO])) break; if (_sp > XB_SPIN_CAP) { atomicAdd(&(bar)[XB_TMO], 1u); break; } } } } while (0)

struct XcdBarrier {
    unsigned* bar; unsigned x;
    volatile LAS unsigned* st;
};

__device__ __forceinline__ XcdBarrier xcd_barrier_post(unsigned* bar, volatile LAS unsigned* st) {
    XcdBarrier b; b.bar = bar; b.x = xb_xcc_id(); b.st = st;
    if (threadIdx.x == 0) (void)xb_add(&bar[XB_XCNT(b.x)], 1u);
    return b;
}
__device__ __forceinline__ void xcd_barrier_complete(unsigned* bar, unsigned x, unsigned& nloc, unsigned& nx) {
    const unsigned G = gridDim.x * gridDim.y * gridDim.z;
    unsigned sum, cnt, mine, sp = 0u;
    for (;;) {
        sum = 0u; cnt = 0u; mine = 0u;
#pragma unroll
        for (unsigned j = 0; j < 16; ++j) { const unsigned c = xb_ld(&bar[XB_XCNT(j)]); sum += c; cnt += (c > 0u) ? 1u : 0u; mine = (j == x) ? c : mine; }
        if (sum == G) break;
        __builtin_amdgcn_s_sleep(1);
        if ((++sp & 255u) == 0u) { if (xb_ld(&bar[XB_TMO])) break; if (sp > XB_SPIN_CAP) { atomicAdd(&bar[XB_TMO], 1u); break; } }
    }
    nloc = mine > 0u ? mine : 1u; nx = cnt > 0u ? cnt : 1u;
}

__device__ __forceinline__ void xcd_barrier(const XcdBarrier& b) {
    asm volatile("s_waitcnt vmcnt(0)" ::: "memory");
    __syncthreads();
    if (threadIdx.x == 0) {
        unsigned* bar = b.bar;
        __builtin_amdgcn_s_waitcnt(0);
        unsigned nloc = b.st[0], nx = b.st[1];
        if (nloc == 0u) { xcd_barrier_complete(bar, b.x, nloc, nx); b.st[0] = nloc; b.st[1] = nx; }
        const unsigned old = xb_add(&bar[XB_XSUB(b.x)], 1u);
        const unsigned gen = old / nloc;
        if (old + 1u == (gen + 1u) * nloc) {
            __builtin_amdgcn_fence(__ATOMIC_RELEASE, "agent");
            asm volatile("s_waitcnt vmcnt(0)" ::: "memory");
            const unsigned og = xb_add(&bar[XB_TOP], 1u);
            const unsigned tg = og / nx;
            if (og + 1u == (tg + 1u) * nx) xb_add(&bar[XB_TOPGEN], 1u);
            else XB_SPIN(xb_ld(&bar[XB_TOPGEN]) == tg, bar);
            __builtin_amdgcn_fence(__ATOMIC_ACQUIRE, "agent");
            xb_add(&bar[XB_XGEN(b.x)], 1u);
            asm volatile("s_waitcnt vmcnt(0)" ::: "memory");
        } else {
            XB_SPIN(xb_ld(&bar[XB_XGEN(b.x)]) == gen, bar);
            __builtin_amdgcn_fence(__ATOMIC_ACQUIRE, "agent");
            asm volatile("s_waitcnt vmcnt(0)" ::: "memory");
        }
    }
    __syncthreads();
}
constexpr int NWAVES = 8;
constexpr int RING_BYTES = 131072;
constexpr int LDSCTL_OFF = RING_BYTES, MISC_OFF = LDSCTL_OFF + 320;
constexpr int LDS_BYTES = 147456;
struct Args { const float* in[19]; float* out; unsigned char* ws; int ph_lo, ph_hi; };
struct Frame {
    LAS unsigned char* lds; volatile LAS unsigned* MISC; unsigned* ctl;
    int tid, lane, wave, vcu, G;
    const float *x_prompt, *x_sample, *state_conv, *state_delta, *cache_k, *cache_v, *c_prompt, *c_sample, *w_ada, *b_ada, *w_in, *conv_w, *a_log, *dt_bias, *norm_a, *sinks, *w_out, *ln_g, *ln_b;
    float* out; unsigned char* ws;
};
__device__ __forceinline__ float wave_sum(float v) {
#pragma unroll
    for (int o = 1; o < 64; o <<= 1) v += __shfl_xor(v, o);
    return v;
}
__device__ __forceinline__ void p0_transpose_item(const float* W, int K, int N, int nblk, bf16_t* WT, LAS float* scr, int item, int lane) {
    const int kb = item / nblk, nb = item % nblk, k0 = 64 * kb, n0 = 32 * nb;
    const int nsrc = n0 + (lane & 31);
#pragma unroll 8
    for (int i = 0; i < 32; ++i) { const int kk = 2 * i + (lane >> 5); scr[kk * 33 + (lane & 31)] = nsrc < N ? W[(size_t)(k0 + kk) * N + nsrc] : 0.f; }
    LDS_WAIT(); asm volatile("" ::: "memory");
    const int c = lane & 7;
#pragma unroll
    for (int j = 0; j < 4; ++j) { const int n = (lane >> 3) + 8 * j; const LAS float* s = scr + (8 * c) * 33 + n;
        u32x4 o; o.x = pk2(s[0 * 33], s[1 * 33]); o.y = pk2(s[2 * 33], s[3 * 33]); o.z = pk2(s[4 * 33], s[5 * 33]); o.w = pk2(s[6 * 33], s[7 * 33]);
        *(u32x4*)(WT + (size_t)(n0 + n) * K + k0 + 8 * c) = o; }
    LDS_WAIT(); asm volatile("" ::: "memory");
}
__device__ __forceinline__ void p0_mod_unit(Frame& F, int u) {
    const int ct = u % 48, kc = u / 48;
    LAS float* cs = (LAS float*)F.lds;
    for (int e = F.tid; e < 136 * 128; e += 512) { const int r = e >> 7, k = e & 127;
        float v = 0.f; if (r < 2) v = F.c_prompt[r * 1024 + kc * 128 + k]; else if (r < 130) v = F.c_sample[(r - 2) * 1024 + kc * 128 + k]; cs[e] = v; }
    __syncthreads();
    const int col = F.tid & 63, rg = F.wave;
    float acc[17];
#pragma unroll
    for (int i = 0; i < 17; ++i) acc[i] = 0.f;
    const float* wp = F.w_ada + (size_t)(kc * 128) * 3072 + ct * 64 + col;
    for (int k = 0; k < 128; k += 4) {
        const float w0 = wp[(size_t)(k + 0) * 3072], w1 = wp[(size_t)(k + 1) * 3072], w2 = wp[(size_t)(k + 2) * 3072], w3 = wp[(size_t)(k + 3) * 3072];
#pragma unroll
        for (int i = 0; i < 17; ++i) { const f32x4 c4 = *(const LAS f32x4*)&cs[(rg + 8 * i) * 128 + k]; acc[i] = fmaf(c4.x, w0, fmaf(c4.y, w1, fmaf(c4.z, w2, fmaf(c4.w, w3, acc[i])))); }
    }
    float* slab = (float*)(F.ws + WS_SLAB) + (size_t)kc * 130 * 3072;
#pragma unroll
    for (int i = 0; i < 17; ++i) { const int r = rg + 8 * i; if (r < 130) slab[(size_t)r * 3072 + ct * 64 + col] = acc[i]; }
    __syncthreads();
}
__device__ __forceinline__ void p0_prologue(Frame& F) {
    for (int u = F.vcu; u < 384; u += F.G) p0_mod_unit(F, u);
    LAS float* scr = (LAS float*)(F.lds + F.wave * 16384);
    const int gw = F.vcu * NWAVES + F.wave, NGW = F.G * NWAVES;
    constexpr int I_IN = 16 * (PLD / 32), I_OUT = 16 * 32;
    for (int it = gw; it < I_IN + I_OUT; it += NGW) {
        if (it < I_IN) p0_transpose_item(F.w_in, 1024, PROJ_COLS, PLD / 32, (bf16_t*)(F.ws + WS_WIN), scr, it, F.lane);
        else p0_transpose_item(F.w_out, 1024, 1024, 32, (bf16_t*)(F.ws + WS_WOUT), scr, it - I_IN, F.lane);
    }
    float* ct = (float*)(F.ws + WS_ROPE); float* st = ct + 8193 * 32;
    for (int e = F.vcu * 512 + F.tid; e < 8193 * 32; e += F.G * 512) { float c, s; rope_cs(e >> 5, e & 31, c, s); ct[e] = c; st[e] = s; }
}
__device__ __forceinline__ void p1_h(Frame& F) {
    LAS float* ms = (LAS float*)F.lds;
    const float* slab = (const float*)(F.ws + WS_SLAB);
    for (int e = F.tid; e < 4096; e += 512) { const int b = e >> 11, c = e & 2047; float s = F.b_ada[c];
#pragma unroll
        for (int kc = 0; kc < 8; ++kc) s += slab[((size_t)kc * 130 + b) * 3072 + c];
        ms[e] = s; }
    float* mod = (float*)(F.ws + WS_MOD);
    for (int e = F.vcu * 512 + F.tid; e < 130 * 3072; e += F.G * 512) { const int c = e % 3072; float s = F.b_ada[c];
#pragma unroll
        for (int kc = 0; kc < 8; ++kc) s += slab[(size_t)kc * 130 * 3072 + e];
        mod[e] = s; }
    __syncthreads();
    bf16_t* h = (bf16_t*)(F.ws + WS_H);
    const int gw = F.vcu * NWAVES + F.wave, NGW = F.G * NWAVES;
    for (int row = gw; row < MPAD; row += NGW) {
        u32x2* o8 = (u32x2*)(h + (size_t)row * 1024) + F.lane;
        if (row >= MT) {
#pragma unroll
            for (int j = 0; j < 4; ++j) o8[64 * j] = (u32x2){0u, 0u};
            continue; }
        const float* xr = row < MP ? F.x_prompt + (size_t)row * 1024 : F.x_sample + (size_t)(row - MP) * 1024;
#pragma unroll
        for (int j = 0; j < 4; ++j) {
            const int c = 4 * F.lane + 256 * j;
            const f32x4 xv = *(const f32x4*)(xr + c);
            f32x4 sh, sc;
            if (row < MP) { const int b = row >> 13; sh = *(const LAS f32x4*)&ms[b * 2048 + c]; sc = *(const LAS f32x4*)&ms[b * 2048 + 1024 + c]; }
            else { const int r = 2 + row - MP; sh = *(const f32x4*)(F.b_ada + c); sc = *(const f32x4*)(F.b_ada + 1024 + c);
#pragma unroll
                for (int kc = 0; kc < 8; ++kc) { sh += *(const f32x4*)(slab + ((size_t)kc * 130 + r) * 3072 + c); sc += *(const f32x4*)(slab + ((size_t)kc * 130 + r) * 3072 + 1024 + c); } }
            const f32x4 hv = xv * (sc + 1.0f) + sh;
            o8[64 * j] = (u32x2){pk2(hv.x, hv.y), pk2(hv.z, hv.w)};
        }
    }
}
constexpr size_t WS_QF = WS_X, WS_OF = WS_X + 16 * MiB, WS_SF = WS_X + 32 * MiB, WS_GL = 27 * MiB;
constexpr int E1_SQ = 136, E1_ST = 72;
constexpr int E1_QS = 0, E1_KS = 17408, E1_KT = 35840, E1_VT = 54272, E1_LF = 72704, E1_T1 = 91136, E1_T2 = 100352, E1_AQ = 109568, E1_YT = 118784, E1_SM = 123008;
constexpr int E1_LL = 68;
__device__ __forceinline__ bf16x8 lds_frag(const LAS unsigned char* base, int stride_el, int row0, int ks, int lane) {
    return *(const LAS bf16x8*)(base + ((row0 + (lane & 15)) * stride_el + 32 * ks + 8 * (lane >> 4)) * 2);
}
#define MFMA16(a, b, c) __builtin_amdgcn_mfma_f32_16x16x32_bf16((a), (b), (c), 0, 0, 0)
__device__ __forceinline__ void wg_barrier() { asm volatile("s_waitcnt vmcnt(0) lgkmcnt(0)" ::: "memory"); __builtin_amdgcn_s_barrier(); asm volatile("" ::: "memory"); }
__device__ __forceinline__ void lds_barrier() { asm volatile("s_waitcnt lgkmcnt(0)" ::: "memory"); __builtin_amdgcn_s_barrier(); asm volatile("" ::: "memory"); }

__device__ __forceinline__ void e1_item(Frame& F, int cidx) {
    const int tid = F.tid, lane = F.lane, w = F.wave, q4 = lane >> 4, c16 = lane & 15;
    const int bh = cidx >> 7, ch = cidx & 127, b = bh >> 2, hd = bh & 3;
    const bf16_t* proj = (const bf16_t*)(F.ws + WS_PROJ);
    const size_t rbase = (size_t)b * SEQ + (size_t)ch * 64;
    LAS unsigned char* L = F.lds;
    LAS float* SM = (LAS float*)(L + E1_SM);
    if (w == 0) {
        const float pb = bf2f(proj[(rbase + lane) * PLD + OFF_A_BETA + hd]), pd = bf2f(proj[(rbase + lane) * PLD + OFF_A_DECAY + hd]);
        const float bt = sigmoidf_(pb);
        float G = -__expf(F.a_log[hd]) * softplusf_(pd + F.dt_bias[hd]);
#pragma unroll
        for (int o = 1; o < 64; o <<= 1) { const float t = __shfl_up(G, o); if (lane >= o) G += t; }
        const float Glast = __shfl(G, 63);
        const float eg = __expf(G);
        SM[lane] = G; SM[64 + lane] = bt; SM[128 + lane] = eg; SM[192 + lane] = __expf(Glast - G); SM[256 + lane] = bt * eg;
        if (lane == 63) ((float*)(F.ws + WS_GL))[cidx] = eg;
    }
    {
        const int cg = tid & 15, tp = tid >> 4;
#pragma unroll
        for (int part = 0; part < 3; ++part) {
            const int col0 = part * 512 + hd * 128 + 8 * cg;
            float wj[4][8];
#pragma unroll
            for (int j = 0; j < 4; ++j) { const f32x4 a = *(const f32x4*)(F.conv_w + j * A_QKV + col0), bq = *(const f32x4*)(F.conv_w + j * A_QKV + col0 + 4);
                wj[j][0] = a.x; wj[j][1] = a.y; wj[j][2] = a.z; wj[j][3] = a.w; wj[j][4] = bq.x; wj[j][5] = bq.y; wj[j][6] = bq.z; wj[j][7] = bq.w; }
            float rows[5][8];
#pragma unroll
            for (int i = 0; i < 5; ++i) {
                const int tl = ch * 64 + 2 * tp - 3 + i;
                bf16x8 v = (bf16x8){0, 0, 0, 0, 0, 0, 0, 0};
                if (tl >= 0) v = *(const bf16x8*)(proj + ((size_t)b * SEQ + tl) * PLD + col0);
#pragma unroll
                for (int e = 0; e < 8; ++e) rows[i][e] = bf2f((bf16_t)v[e]);
            }
            if (ch == 127 && tp == 31) {
#pragma unroll
                for (int i = 0; i < 3; ++i)
#pragma unroll
                    for (int e = 0; e < 8; ++e) F.out[O_CONVP + ((size_t)b * 3 + i) * A_QKV + col0 + e] = rows[2 + i][e];
            }
            float val[2][8]; float ss[2] = {0.f, 0.f};
#pragma unroll
            for (int tt = 0; tt < 2; ++tt)
#pragma unroll
                for (int e = 0; e < 8; ++e) { float a = 0.f;
#pragma unroll
                    for (int j = 0; j < 4; ++j) a = fmaf(rows[tt + j][e], wj[j][e], a);
                    a = siluf(a); val[tt][e] = a; ss[tt] = fmaf(a, a, ss[tt]); }
            if (part < 2) {
#pragma unroll
                for (int tt = 0; tt < 2; ++tt) {
                    float s = ss[tt]; s += __shfl_xor(s, 1); s += __shfl_xor(s, 2); s += __shfl_xor(s, 4); s += __shfl_xor(s, 8);
                    const float sc = rsqrtf(s + L2_EPS) * (part == 0 ? 0.08838834764831845f : 1.f);
#pragma unroll
                    for (int e = 0; e < 8; ++e) val[tt][e] *= sc;
                }
            }
            if (part < 2) {
                LAS unsigned char* dst = L + (part == 0 ? E1_QS : E1_KS);
#pragma unroll
                for (int tt = 0; tt < 2; ++tt) { u32x4 o; o.x = pk2(val[tt][0], val[tt][1]); o.y = pk2(val[tt][2], val[tt][3]); o.z = pk2(val[tt][4], val[tt][5]); o.w = pk2(val[tt][6], val[tt][7]);
                    *(LAS u32x4*)(dst + ((2 * tp + tt) * E1_SQ + 8 * cg) * 2) = o; }
            }
            if (part >= 1) {
                LAS unsigned char* dst = L + (part == 1 ? E1_KT : E1_VT);
#pragma unroll
                for (int e = 0; e < 8; ++e) *(LAS unsigned*)(dst + ((8 * cg + e) * E1_ST + 2 * tp) * 2) = pk2(val[0][e], val[1][e]);
            }
        }
    }
    lds_barrier();
    {
        LAS float* Lf = (LAS float*)(L + E1_LF);
#pragma unroll 1
        for (int jb = w; jb < 32; jb += 8) {
            const int which = jb >> 4, mi = (jb >> 2) & 3, ni = jb & 3;
            f32x4 acc = (f32x4){0.f, 0.f, 0.f, 0.f};
            if (ni <= mi) {
#pragma unroll
                for (int ks = 0; ks < 4; ++ks) acc = MFMA16(lds_frag(L + (which ? E1_QS : E1_KS), E1_SQ, 16 * mi, ks, lane), lds_frag(L + E1_KS, E1_SQ, 16 * ni, ks, lane), acc);
            }
            const int i = 16 * ni + c16; const float Gi = SM[i];
#pragma unroll
            for (int r = 0; r < 4; ++r) {
                const int t = 16 * mi + 4 * q4 + r; const float Gt = SM[t];
                const float dec = __expf(fminf(Gt - Gi, 0.f));
                if (which == 0) Lf[t * E1_LL + i] = (t > i) ? SM[64 + t] * acc[r] * dec : 0.f;
                else *(LAS bf16_t*)(L + E1_AQ + (t * E1_ST + i) * 2) = f2bf((t >= i) ? acc[r] * dec : 0.f);
            }
        }
    }
    lds_barrier();
    {
        LAS float* Lf = (LAS float*)(L + E1_LF); LAS float* Yt = (LAS float*)(L + E1_YT);
        if (w == 0) {
            const int bb = lane >> 4, j = lane & 15;
            float x[16];
#pragma unroll
            for (int t = 0; t < 16; ++t) { float a = (t == j) ? 1.f : 0.f;
#pragma unroll
                for (int i = 0; i < t; ++i) a = fmaf(-Lf[(16 * bb + t) * E1_LL + 16 * bb + i], x[i], a);
                x[t] = a; }
            asm volatile("s_waitcnt lgkmcnt(0)" ::: "memory");
#pragma unroll
            for (int t = 0; t < 16; ++t) Lf[(16 * bb + t) * E1_LL + 16 * bb + j] = x[t];
        }
        lds_barrier();
        {
            const int p = tid >> 8, r = (tid >> 4) & 15, c = tid & 15, a = 32 * p;
            float y = 0.f;
#pragma unroll
            for (int k = 0; k < 16; ++k) y = fmaf(Lf[(a + 16 + r) * E1_LL + a + k], Lf[(a + k) * E1_LL + a + c], y);
            Yt[p * 16 * 33 + r * 33 + c] = y;
            lds_barrier();
            float pv = 0.f;
#pragma unroll
            for (int k = 0; k < 16; ++k) pv = fmaf(Lf[(a + 16 + r) * E1_LL + a + 16 + k], Yt[p * 16 * 33 + k * 33 + c], pv);
            lds_barrier();
            Lf[(a + 16 + r) * E1_LL + a + c] = -pv;
        }
        lds_barrier();
        {
            float y[2], pv[2];
#pragma unroll
            for (int u = 0; u < 2; ++u) { const int o = tid + 512 * u, r = o >> 5, c = o & 31; float s = 0.f;
#pragma unroll 8
                for (int k = 0; k < 32; ++k) s = fmaf(Lf[(32 + r) * E1_LL + k], Lf[k * E1_LL + c], s);
                y[u] = s; }
#pragma unroll
            for (int u = 0; u < 2; ++u) { const int o = tid + 512 * u; Yt[(o >> 5) * 33 + (o & 31)] = y[u]; }
            lds_barrier();
#pragma unroll
            for (int u = 0; u < 2; ++u) { const int o = tid + 512 * u, r = o >> 5, c = o & 31; float s = 0.f;
#pragma unroll 8
                for (int k = 0; k < 32; ++k) s = fmaf(Lf[(32 + r) * E1_LL + 32 + k], Yt[k * 33 + c], s);
                pv[u] = s; }
            lds_barrier();
#pragma unroll
            for (int u = 0; u < 2; ++u) { const int o = tid + 512 * u; Lf[(32 + (o >> 5)) * E1_LL + (o & 31)] = -pv[u]; }
        }
        lds_barrier();
#pragma unroll
        for (int u = 0; u < 8; ++u) { const int o = tid + 512 * u, t = o >> 6, i = o & 63; const float tv = Lf[t * E1_LL + i];
            *(LAS bf16_t*)(L + E1_T1 + (t * E1_ST + i) * 2) = f2bf(tv * SM[256 + i]); *(LAS bf16_t*)(L + E1_T2 + (t * E1_ST + i) * 2) = f2bf(tv * SM[64 + i]); }
    }
    lds_barrier();
    {
#pragma unroll 1
        for (int jb = w; jb < 64; jb += 8) {
            const int which = jb >> 5, mi = (jb >> 3) & 3, ni = jb & 7;
            f32x4 acc = (f32x4){0.f, 0.f, 0.f, 0.f};
#pragma unroll
            for (int ks = 0; ks < 2; ++ks) acc = MFMA16(lds_frag(L + (which ? E1_T2 : E1_T1), E1_ST, 16 * mi, ks, lane), lds_frag(L + (which ? E1_VT : E1_KT), E1_ST, 16 * ni, ks, lane), acc);
            *(LAS u32x2*)(L + (which ? E1_LF : E1_KS) + ((16 * ni + c16) * E1_ST + 16 * mi + 4 * q4) * 2) = (u32x2){pk2(acc[0], acc[1]), pk2(acc[2], acc[3])};
        }
    }
    lds_barrier();
    {
        const int d = tid >> 2, t0 = (tid & 3) * 16;
        LAS bf16_t* p = (LAS bf16_t*)(L + E1_KT) + d * E1_ST + t0;
#pragma unroll
        for (int e = 0; e < 16; ++e) p[e] = f2bf(bf2f(p[e]) * SM[192 + t0 + e]);
    }
    lds_barrier();
    {
        const LAS unsigned char* WT = L + E1_KS; const LAS unsigned char* UT = L + E1_LF; const LAS unsigned char* KdT = L + E1_KT; const LAS unsigned char* AQ = L + E1_AQ;
        bf16_t* MF = (bf16_t*)F.out + (size_t)cidx * 16384;
        bf16_t* BF = (bf16_t*)((unsigned char*)F.out + 32 * MiB) + (size_t)cidx * 16384;
        bf16_t* QF = (bf16_t*)(F.ws + WS_QF) + (size_t)cidx * 8192;
        bf16_t* OFp = (bf16_t*)(F.ws + WS_OF) + (size_t)cidx * 8192;
        {
            const bf16x8 b0 = lds_frag(KdT, E1_ST, 16 * w, 0, lane), b1 = lds_frag(KdT, E1_ST, 16 * w, 1, lane);
#pragma unroll
            for (int kp = 0; kp < 4; ++kp) {
                f32x4 a0 = (f32x4){0.f, 0.f, 0.f, 0.f}, a1 = a0;
                a0 = MFMA16(lds_frag(WT, E1_ST, 16 * (2 * kp), 0, lane), b0, a0); a0 = MFMA16(lds_frag(WT, E1_ST, 16 * (2 * kp), 1, lane), b1, a0);
                a1 = MFMA16(lds_frag(WT, E1_ST, 16 * (2 * kp + 1), 0, lane), b0, a1); a1 = MFMA16(lds_frag(WT, E1_ST, 16 * (2 * kp + 1), 1, lane), b1, a1);
                *(u32x4*)(MF + ((size_t)(w * 4 + kp) * 64 + lane) * 8) = (u32x4){pk2(-a0[0], -a0[1]), pk2(-a0[2], -a0[3]), pk2(-a1[0], -a1[1]), pk2(-a1[2], -a1[3])};
            }
        }
        {
            const bf16x8 b0 = lds_frag(UT, E1_ST, 16 * w, 0, lane), b1 = lds_frag(UT, E1_ST, 16 * w, 1, lane);
#pragma unroll
            for (int kp = 0; kp < 4; ++kp) {
                f32x4 a0 = (f32x4){0.f, 0.f, 0.f, 0.f}, a1 = a0;
                a0 = MFMA16(lds_frag(KdT, E1_ST, 16 * (2 * kp), 0, lane), b0, a0); a0 = MFMA16(lds_frag(KdT, E1_ST, 16 * (2 * kp), 1, lane), b1, a0);
                a1 = MFMA16(lds_frag(KdT, E1_ST, 16 * (2 * kp + 1), 0, lane), b0, a1); a1 = MFMA16(lds_frag(KdT, E1_ST, 16 * (2 * kp + 1), 1, lane), b1, a1);
                *(u32x4*)(BF + ((size_t)(w * 64 + lane) * 8 + 2 * kp) * 4) = (u32x4){pk2(a0[0], a0[1]), pk2(a0[2], a0[3]), pk2(a1[0], a1[1]), pk2(a1[2], a1[3])};
            }
#pragma unroll
            for (int kp = 0; kp < 2; ++kp) {
                f32x4 a0 = (f32x4){0.f, 0.f, 0.f, 0.f}, a1 = a0;
                a0 = MFMA16(lds_frag(AQ, E1_ST, 16 * (2 * kp), 0, lane), b0, a0); a0 = MFMA16(lds_frag(AQ, E1_ST, 16 * (2 * kp), 1, lane), b1, a0);
                a1 = MFMA16(lds_frag(AQ, E1_ST, 16 * (2 * kp + 1), 0, lane), b0, a1); a1 = MFMA16(lds_frag(AQ, E1_ST, 16 * (2 * kp + 1), 1, lane), b1, a1);
                *(u32x4*)(OFp + ((size_t)(w * 64 + lane) * 4 + 2 * kp) * 4) = (u32x4){pk2(a0[0], a0[1]), pk2(a0[2], a0[3]), pk2(a1[0], a1[1]), pk2(a1[2], a1[3])};
            }
        }
        {
            const int ni = w & 3, t = 16 * ni + c16; const float eg = SM[128 + t];
            const bf16x8 b0 = lds_frag(AQ, E1_ST, 16 * ni, 0, lane), b1 = lds_frag(AQ, E1_ST, 16 * ni, 1, lane);
#pragma unroll
            for (int kk = 0; kk < 2; ++kk) {
                const int ks = 2 * (w >> 2) + kk;
                f32x4 a0 = (f32x4){0.f, 0.f, 0.f, 0.f}, a1 = a0;
                a0 = MFMA16(lds_frag(WT, E1_ST, 16 * (2 * ks), 0, lane), b0, a0); a0 = MFMA16(lds_frag(WT, E1_ST, 16 * (2 * ks), 1, lane), b1, a0);
                a1 = MFMA16(lds_frag(WT, E1_ST, 16 * (2 * ks + 1), 0, lane), b0, a1); a1 = MFMA16(lds_frag(WT, E1_ST, 16 * (2 * ks + 1), 1, lane), b1, a1);
                const u32x2 q0 = *(const LAS u32x2*)(L + E1_QS + (t * E1_SQ + 16 * (2 * ks) + 4 * q4) * 2), q1 = *(const LAS u32x2*)(L + E1_QS + (t * E1_SQ + 16 * (2 * ks + 1) + 4 * q4) * 2);
                const float v0 = eg * __uint_as_float(q0.x << 16) - a0[0], v1 = eg * __uint_as_float(q0.x & 0xffff0000u) - a0[1], v2 = eg * __uint_as_float(q0.y << 16) - a0[2], v3 = eg * __uint_as_float(q0.y & 0xffff0000u) - a0[3];
                const float v4 = eg * __uint_as_float(q1.x << 16) - a1[0], v5 = eg * __uint_as_float(q1.x & 0xffff0000u) - a1[1], v6 = eg * __uint_as_float(q1.y << 16) - a1[2], v7 = eg * __uint_as_float(q1.y & 0xffff0000u) - a1[3];
                *(u32x4*)(QF + ((size_t)(ni * 4 + ks) * 64 + lane) * 8) = (u32x4){pk2(v0, v1), pk2(v2, v3), pk2(v4, v5), pk2(v6, v7)};
            }
        }
    }
    wg_barrier();
}

__device__ __forceinline__ void scan_unit(Frame& F, int bh, int s) {
    const int lane = F.lane, i = F.wave;
    LAS unsigned char* L = F.lds;
    const bf16_t* MF = (const bf16_t*)F.out; const bf16_t* BF = (const bf16_t*)((unsigned char*)F.out + 32 * MiB);
    bf16_t* SF = (bf16_t*)(F.ws + WS_SF); const float* GL = (const float*)(F.ws + WS_GL);
    for (int e = F.tid; e < 2048; e += 512) ((LAS unsigned*)L)[e] = 0u;
    f32x4 acc = (f32x4){0.f, 0.f, 0.f, 0.f};
    const size_t c0 = (size_t)bh * 128;
    constexpr int PF = 4;
    bf16x8 A[PF][4]; u32x2 Bc[PF]; float gl[PF];
#define SCAN_LOAD(slot, cc) do { const size_t ci_ = c0 + (cc); _Pragma("unroll") for (int ks = 0; ks < 4; ++ks) A[slot][ks] = *(const bf16x8*)(MF + ((ci_ * 8 + i) * 4 + ks) * 512 + lane * 8); \
        Bc[slot] = *(const u32x2*)(BF + ((ci_ * 8 + s) * 64 + lane) * 32 + i * 4); gl[slot] = GL[ci_]; } while (0)
#pragma unroll
    for (int p = 0; p < PF; ++p) SCAN_LOAD(p, p);
    lds_barrier();
    for (int cb = 0; cb < 128; cb += PF) {
#pragma unroll
        for (int p = 0; p < PF; ++p) {
            const int c = cb + p, cur = p & 1;
            const size_t ci = c0 + c;
            bf16x8 Sf[4];
#pragma unroll
            for (int ks = 0; ks < 4; ++ks) Sf[ks] = *(const LAS bf16x8*)(L + cur * 4096 + (ks * 64 + lane) * 16);
            if (i < 4) *(bf16x8*)(SF + ((ci * 8 + s) * 4 + i) * 512 + lane * 8) = *(const LAS bf16x8*)(L + cur * 4096 + (i * 64 + lane) * 16);
            const float g = gl[p];
            acc[0] = fmaf(g, acc[0], __uint_as_float(Bc[p].x << 16)); acc[1] = fmaf(g, acc[1], __uint_as_float(Bc[p].x & 0xffff0000u));
            acc[2] = fmaf(g, acc[2], __uint_as_float(Bc[p].y << 16)); acc[3] = fmaf(g, acc[3], __uint_as_float(Bc[p].y & 0xffff0000u));
#pragma unroll
            for (int ks = 0; ks < 4; ++ks) acc = MFMA16(A[p][ks], Sf[ks], acc);
            *(LAS u32x2*)(L + (cur ^ 1) * 4096 + ((i >> 1) * 64 + lane) * 16 + (i & 1) * 8) = (u32x2){pk2(acc[0], acc[1]), pk2(acc[2], acc[3])};
            if (c + PF < 128) SCAN_LOAD(p, c + PF);
            lds_barrier();
        }
    }
#undef SCAN_LOAD
    float* dp = F.out + O_DELTAP + (size_t)bh * 128 * 128;
#pragma unroll
    for (int r = 0; r < 4; ++r) dp[(size_t)(16 * i + 4 * (lane >> 4) + r) * 128 + 16 * s + (lane & 15)] = acc[r];
    wg_barrier();
}

__device__ __forceinline__ void o_item(Frame& F, int cidx) {
    const int tid = F.tid, lane = F.lane, w = F.wave, q4 = lane >> 4, c16 = lane & 15;
    const int bh = cidx >> 7, ch = cidx & 127, b = bh >> 2, hd = bh & 3;
    const bf16_t* QF = (const bf16_t*)(F.ws + WS_QF) + (size_t)cidx * 8192; const bf16_t* OFp = (const bf16_t*)(F.ws + WS_OF) + (size_t)cidx * 8192;
    const bf16_t* SF = (const bf16_t*)(F.ws + WS_SF) + (size_t)cidx * 16384;
    LAS float* Of = (LAS float*)F.lds;
    bf16x8 Sf[4];
#pragma unroll
    for (int ks = 0; ks < 4; ++ks) Sf[ks] = *(const bf16x8*)(SF + ((size_t)(w * 4 + ks) * 64 + lane) * 8);
    const u32x4 o01 = *(const u32x4*)(OFp + ((size_t)(w * 64 + lane) * 4) * 4), o23 = *(const u32x4*)(OFp + ((size_t)(w * 64 + lane) * 4 + 2) * 4);
    const unsigned ow[8] = {o01.x, o01.y, o01.z, o01.w, o23.x, o23.y, o23.z, o23.w};
#pragma unroll
    for (int mt = 0; mt < 4; ++mt) {
        f32x4 acc = (f32x4){__uint_as_float(ow[2 * mt] << 16), __uint_as_float(ow[2 * mt] & 0xffff0000u), __uint_as_float(ow[2 * mt + 1] << 16), __uint_as_float(ow[2 * mt + 1] & 0xffff0000u)};
#pragma unroll
        for (int ks = 0; ks < 4; ++ks) acc = MFMA16(*(const bf16x8*)(QF + ((size_t)(mt * 4 + ks) * 64 + lane) * 8), Sf[ks], acc);
#pragma unroll
        for (int r = 0; r < 4; ++r) Of[(16 * mt + 4 * q4 + r) * 132 + 16 * w + c16] = acc[r];
    }
    lds_barrier();
    {
        const int t = tid >> 3, cs = tid & 7;
        float v[16]; float ss = 0.f;
#pragma unroll
        for (int u = 0; u < 4; ++u) { const f32x4 x = *(const LAS f32x4*)&Of[t * 132 + 16 * cs + 4 * u]; v[4 * u] = x.x; v[4 * u + 1] = x.y; v[4 * u + 2] = x.z; v[4 * u + 3] = x.w; ss += x.x * x.x + x.y * x.y + x.z * x.z + x.w * x.w; }
        ss += __shfl_xor(ss, 1); ss += __shfl_xor(ss, 2); ss += __shfl_xor(ss, 4);
        const float rs = rsqrtf(ss * (1.f / 128.f) + RMS_EPS);
        const size_t row = (size_t)b * SEQ + (size_t)ch * 64 + t;
        const bf16_t* zp = (const bf16_t*)(F.ws + WS_PROJ) + row * PLD + OFF_A_Z + hd * 128 + 16 * cs;
        const bf16x8 z0 = *(const bf16x8*)zp, z1 = *(const bf16x8*)(zp + 8);
        float o[16];
#pragma unroll
        for (int e = 0; e < 16; ++e) { const float z = bf2f((bf16_t)(e < 8 ? z0[e] : z1[e - 8])); o[e] = v[e] * rs * F.norm_a[16 * cs + e] * siluf(z); }
        bf16_t* mp = (bf16_t*)(F.ws + WS_H) + row * 1024 + hd * 128 + 16 * cs;
        *(u32x4*)mp = (u32x4){pk2(o[0], o[1]), pk2(o[2], o[3]), pk2(o[4], o[5]), pk2(o[6], o[7])};
        *(u32x4*)(mp + 8) = (u32x4){pk2(o[8], o[9]), pk2(o[10], o[11]), pk2(o[12], o[13]), pk2(o[14], o[15])};
    }
    wg_barrier();
}
typedef float f32x16 __attribute__((ext_vector_type(16)));
#define MFMA32(a, b, c) __builtin_amdgcn_mfma_f32_32x32x16_bf16((a), (b), (c), 0, 0, 0)
constexpr int SW_KST = 72, SW_VST = 260;
constexpr int SW_K = 0, SW_VT = 36864, SW_INV = SW_VT + 33280;
__device__ __forceinline__ void swa_item(Frame& F, int item) {
    const int tid = F.tid, lane = F.lane, w = F.wave, l31 = lane & 31, hh = lane >> 5;
    const int nblk = item & 63, kvh = (item >> 6) & 1, b = item >> 7;
    const bf16_t* proj = (const bf16_t*)(F.ws + WS_PROJ);
    const float* cosT = (const float*)(F.ws + WS_ROPE); const float* sinT = cosT + 8193 * 32;
    LAS unsigned char* L = F.lds;
    {
        const int j = tid >> 1, half = tid & 1;
        const int pos = (nblk - 1) * 128 + j;
        float k1[16], k2[16];
        if (pos >= 0) {
            const bf16_t* kp = proj + ((size_t)b * SEQ + pos) * PLD + OFF_B_K + kvh * 64 + 16 * half;
            const bf16x8 a0 = *(const bf16x8*)kp, a1 = *(const bf16x8*)(kp + 8), c0 = *(const bf16x8*)(kp + 32), c1 = *(const bf16x8*)(kp + 40);
#pragma unroll
            for (int e = 0; e < 8; ++e) { k1[e] = bf2f((bf16_t)a0[e]); k1[8 + e] = bf2f((bf16_t)a1[e]); k2[e] = bf2f((bf16_t)c0[e]); k2[8 + e] = bf2f((bf16_t)c1[e]); }
            float r1[16], r2[16];
#pragma unroll
            for (int u = 0; u < 4; ++u) { const f32x4 cc = *(const f32x4*)(cosT + pos * 32 + 16 * half + 4 * u), sn = *(const f32x4*)(sinT + pos * 32 + 16 * half + 4 * u);
#pragma unroll
                for (int e = 0; e < 4; ++e) { const float c = cc[e], s = sn[e], x1 = k1[4 * u + e], x2 = k2[4 * u + e]; r1[4 * u + e] = x1 * c - x2 * s; r2[4 * u + e] = x2 * c + x1 * s; } }
#pragma unroll
            for (int e = 0; e < 16; ++e) { k1[e] = r1[e]; k2[e] = r2[e]; }
            if (nblk == 63 && j >= 128) {
                float* ko = F.out + O_KP + (((size_t)b * WINDOW + (j - 128)) * 2 + kvh) * 64;
#pragma unroll
                for (int u = 0; u < 4; ++u) { *(f32x4*)(ko + 16 * half + 4 * u) = (f32x4){k1[4 * u], k1[4 * u + 1], k1[4 * u + 2], k1[4 * u + 3]}; *(f32x4*)(ko + 32 + 16 * half + 4 * u) = (f32x4){k2[4 * u], k2[4 * u + 1], k2[4 * u + 2], k2[4 * u + 3]}; }
            }
        } else {
#pragma unroll
            for (int e = 0; e < 16; ++e) { k1[e] = 0.f; k2[e] = 0.f; }
        }
        LAS unsigned char* kd = L + SW_K + (j * SW_KST + 16 * half) * 2;
        *(LAS u32x4*)kd = (u32x4){pk2(k1[0], k1[1]), pk2(k1[2], k1[3]), pk2(k1[4], k1[5]), pk2(k1[6], k1[7])};
        *(LAS u32x4*)(kd + 16) = (u32x4){pk2(k1[8], k1[9]), pk2(k1[10], k1[11]), pk2(k1[12], k1[13]), pk2(k1[14], k1[15])};
        *(LAS u32x4*)(kd + 64) = (u32x4){pk2(k2[0], k2[1]), pk2(k2[2], k2[3]), pk2(k2[4], k2[5]), pk2(k2[6], k2[7])};
        *(LAS u32x4*)(kd + 80) = (u32x4){pk2(k2[8], k2[9]), pk2(k2[10], k2[11]), pk2(k2[12], k2[13]), pk2(k2[14], k2[15])};
        LAS bf16_t* vt = (LAS bf16_t*)(L + SW_VT);
        if (pos >= 0) {
            const bf16_t* vp = proj + ((size_t)b * SEQ + pos) * PLD + OFF_B_V + kvh * 64 + 32 * half;
#pragma unroll
            for (int u = 0; u < 4; ++u) { const bf16x8 v = *(const bf16x8*)(vp + 8 * u);
#pragma unroll
                for (int e = 0; e < 8; ++e) vt[(32 * half + 8 * u + e) * SW_VST + j] = (bf16_t)v[e];
                if (nblk == 63 && j >= 128) { float* vo = F.out + O_VP + (((size_t)b * WINDOW + (j - 128)) * 2 + kvh) * 64 + 32 * half + 8 * u;
                    *(f32x4*)vo = (f32x4){bf2f((bf16_t)v[0]), bf2f((bf16_t)v[1]), bf2f((bf16_t)v[2]), bf2f((bf16_t)v[3])}; *(f32x4*)(vo + 4) = (f32x4){bf2f((bf16_t)v[4]), bf2f((bf16_t)v[5]), bf2f((bf16_t)v[6]), bf2f((bf16_t)v[7])}; }
            }
        } else {
#pragma unroll
            for (int e = 0; e < 32; ++e) vt[(32 * half + e) * SW_VST + j] = (bf16_t)0;
        }
    }
    lds_barrier();
    const int hq = kvh * 4 + (w >> 1), qhalf = w & 1;
    const float sink = F.sinks[hq];
    LAS float* inv = (LAS float*)(L + SW_INV + w * 128);
#pragma unroll 1
    for (int qt = 0; qt < 2; ++qt) {
        const int a0 = 64 * qhalf + 32 * qt, a = a0 + l31, kt0 = a0 >> 5;
        const int pos = nblk * 128 + a; const size_t row = (size_t)b * SEQ + pos;
        bf16x8 qf[4];
        {
            const bf16_t* qp = proj + row * PLD + OFF_B_Q + hq * 64 + 8 * hh;
            float x[4][8];
#pragma unroll
            for (int ks = 0; ks < 4; ++ks) { const bf16x8 v = *(const bf16x8*)(qp + 16 * ks);
#pragma unroll
                for (int e = 0; e < 8; ++e) x[ks][e] = bf2f((bf16_t)v[e]); }
#pragma unroll
            for (int ks = 0; ks < 2; ++ks) {
                const float* cp = cosT + pos * 32 + 16 * ks + 8 * hh; const float* sp = sinT + pos * 32 + 16 * ks + 8 * hh;
                const f32x4 c0 = *(const f32x4*)cp, c1 = *(const f32x4*)(cp + 4), s0 = *(const f32x4*)sp, s1 = *(const f32x4*)(sp + 4);
#pragma unroll
                for (int e = 0; e < 8; ++e) { const float c = e < 4 ? c0[e & 3] : c1[e & 3], s = e < 4 ? s0[e & 3] : s1[e & 3]; const float x1 = x[ks][e], x2 = x[ks + 2][e];
                    x[ks][e] = (x1 * c - x2 * s) * 0.125f; x[ks + 2][e] = (x2 * c + x1 * s) * 0.125f; }
            }
#pragma unroll
            for (int ks = 0; ks < 4; ++ks) { const u32x4 pk = (u32x4){pk2(x[ks][0], x[ks][1]), pk2(x[ks][2], x[ks][3]), pk2(x[ks][4], x[ks][5]), pk2(x[ks][6], x[ks][7])}; qf[ks] = __builtin_bit_cast(bf16x8, pk); }
        }
        f32x16 sc[5];
#pragma unroll
        for (int kt = 0; kt < 5; ++kt) {
            f32x16 acc;
#pragma unroll
            for (int r = 0; r < 16; ++r) acc[r] = 0.f;
#pragma unroll
            for (int ks = 0; ks < 4; ++ks) { const bf16x8 kf = *(const LAS bf16x8*)(L + SW_K + ((32 * (kt0 + kt) + l31) * SW_KST + 16 * ks + 8 * hh) * 2); acc = MFMA32(kf, qf[ks], acc); }
            sc[kt] = acc;
        }
        float mx = sink;
#pragma unroll
        for (int kt = 0; kt < 5; ++kt)
#pragma unroll
            for (int r = 0; r < 16; ++r) { const int j = 32 * (kt0 + kt) + (r & 3) + 8 * (r >> 2) + 4 * hh; const int rel = a + 128 - j;
                const bool ok = rel >= 0 && rel <= 128 && (nblk > 0 || j >= 128);
                const float s = ok ? sc[kt][r] : -INFINITY; sc[kt][r] = s; mx = fmaxf(mx, s); }
        mx = fmaxf(mx, __shfl_xor(mx, 32));
        float sum = 0.f;
#pragma unroll
        for (int kt = 0; kt < 5; ++kt)
#pragma unroll
            for (int r = 0; r < 16; ++r) { const float p = __expf(sc[kt][r] - mx); sc[kt][r] = p; sum += p; }
        sum += __shfl_xor(sum, 32);
        sum += __expf(sink - mx);
        if (hh == 0) inv[l31] = 1.f / sum;
        f32x16 o[2];
#pragma unroll
        for (int dt = 0; dt < 2; ++dt)
#pragma unroll
            for (int r = 0; r < 16; ++r) o[dt][r] = 0.f;
#pragma unroll
        for (int kt = 0; kt < 5; ++kt)
#pragma unroll
            for (int s2 = 0; s2 < 2; ++s2) {
                const u32x4 pk = (u32x4){pk2(sc[kt][8 * s2], sc[kt][8 * s2 + 1]), pk2(sc[kt][8 * s2 + 2], sc[kt][8 * s2 + 3]), pk2(sc[kt][8 * s2 + 4], sc[kt][8 * s2 + 5]), pk2(sc[kt][8 * s2 + 6], sc[kt][8 * s2 + 7])};
                const bf16x8 pa = __builtin_bit_cast(bf16x8, pk);
                const int kbase = 32 * (kt0 + kt) + 16 * s2 + 4 * hh;
#pragma unroll
                for (int dt = 0; dt < 2; ++dt) {
                    const LAS unsigned char* vp = L + SW_VT + ((32 * dt + l31) * SW_VST + kbase) * 2;
                    const u32x2 v0 = *(const LAS u32x2*)vp, v1 = *(const LAS u32x2*)(vp + 16);
                    const u32x4 vv = (u32x4){v0.x, v0.y, v1.x, v1.y};
                    o[dt] = MFMA32(pa, __builtin_bit_cast(bf16x8, vv), o[dt]);
                }
            }
        asm volatile("s_waitcnt lgkmcnt(0)" ::: "memory");
#pragma unroll
        for (int r = 0; r < 16; ++r) {
            const int qq = (r & 3) + 8 * (r >> 2) + 4 * hh; const float iv = inv[qq];
            const size_t rw = (size_t)b * SEQ + nblk * 128 + a0 + qq;
#pragma unroll
            for (int dt = 0; dt < 2; ++dt) {
                const float z = bf2f(proj[rw * PLD + OFF_B_Z + hq * 64 + 32 * dt + l31]);
                ((bf16_t*)(F.ws + WS_H))[rw * 1024 + 512 + hq * 64 + 32 * dt + l31] = f2bf(o[dt][r] * iv * siluf(z));
            }
        }
        asm volatile("s_waitcnt lgkmcnt(0)" ::: "memory");
    }
    wg_barrier();
}
__device__ __forceinline__ void sd_item(Frame& F, int item) {
    const int tid = F.tid, lane = F.lane, w = F.wave, b = item >> 2, hd = item & 3;
    const size_t row = (size_t)MP + b;
    const bf16_t* proj = (const bf16_t*)(F.ws + WS_PROJ);
    LAS float* V = (LAS float*)F.lds;
    LAS float* red = V + 384; LAS float* part = V + 400; LAS float* og = V + 400 + 1024;
    float val = 0.f;
    if (tid < 384) {
        const int p = tid >> 7, c = tid & 127, col = p * 512 + hd * 128 + c;
        const float u0 = F.state_conv[((size_t)b * 3 + 0) * A_QKV + col], u1 = F.state_conv[((size_t)b * 3 + 1) * A_QKV + col], u2 = F.state_conv[((size_t)b * 3 + 2) * A_QKV + col];
        const float u3 = bf2f(proj[row * PLD + col]);
        const float a = u0 * F.conv_w[col] + u1 * F.conv_w[A_QKV + col] + u2 * F.conv_w[2 * A_QKV + col] + u3 * F.conv_w[3 * A_QKV + col];
        val = siluf(a);
        float* cs = F.out + O_CONVS + (size_t)b * 3 * A_QKV + col;
        cs[0] = u1; cs[A_QKV] = u2; cs[2 * A_QKV] = u3;
    }
    if (w < 4) { const float s = wave_sum(val * val); if (lane == 0) red[w] = s; }
    lds_barrier();
    if (tid < 384) { const int p = tid >> 7; float sc = 1.f;
        if (p == 0) sc = rsqrtf(red[0] + red[1] + L2_EPS) * 0.08838834764831845f; else if (p == 1) sc = rsqrtf(red[2] + red[3] + L2_EPS);
        V[tid] = val * sc; }
    lds_barrier();
    if (w < 2) { const float s = wave_sum(V[tid] * V[128 + tid]); if (lane == 0) red[4 + w] = s; }
    const float bt = sigmoidf_(bf2f(proj[row * PLD + OFF_A_BETA + hd]));
    const float dec = __expf(-__expf(F.a_log[hd]) * softplusf_(bf2f(proj[row * PLD + OFF_A_DECAY + hd]) + F.dt_bias[hd]));
    const int e = tid & 127, dg = tid >> 7;
    const float* s0 = F.state_delta + ((size_t)(b * 4 + hd) * 128 + 32 * dg) * 128 + e;
    float S[32]; float ks = 0.f, qs = 0.f;
#pragma unroll
    for (int d = 0; d < 32; ++d) S[d] = s0[(size_t)d * 128];
#pragma unroll
    for (int d = 0; d < 32; ++d) { ks = fmaf(V[128 + 32 * dg + d], S[d], ks); qs = fmaf(V[32 * dg + d], S[d], qs); }
    part[dg * 128 + e] = ks; part[512 + dg * 128 + e] = qs;
    lds_barrier();
    const float kS = part[e] + part[128 + e] + part[256 + e] + part[384 + e], qS = part[512 + e] + part[640 + e] + part[768 + e] + part[896 + e];
    const float qk = red[4] + red[5];
    const float u = bt * (V[256 + e] - dec * kS);
    const float o = dec * qS + qk * u;
    float* so = F.out + O_DELTAS + ((size_t)(b * 4 + hd) * 128 + 32 * dg) * 128 + e;
#pragma unroll
    for (int d = 0; d < 32; ++d) so[(size_t)d * 128] = fmaf(V[128 + 32 * dg + d], u, dec * S[d]);
    if (w < 2) { const float s = wave_sum(o * o); if (lane == 0) red[8 + w] = s; }
    lds_barrier();
    if (tid < 128) {
        const float rs = rsqrtf((red[8] + red[9]) * (1.f / 128.f) + RMS_EPS);
        const float z = bf2f(proj[row * PLD + OFF_A_Z + hd * 128 + e]);
        ((bf16_t*)(F.ws + WS_H))[row * 1024 + hd * 128 + e] = f2bf(o * rs * F.norm_a[e] * siluf(z));
    }
    wg_barrier();
}
__device__ __forceinline__ void ss_item(Frame& F, int b) {
    const int tid = F.tid, lane = F.lane, w = F.wave;
    const size_t row = (size_t)MP + b;
    const bf16_t* proj = (const bf16_t*)(F.ws + WS_PROJ);
    const float* cosT = (const float*)(F.ws + WS_ROPE) + (size_t)PAST_LEN * 32; const float* sinT = (const float*)(F.ws + WS_ROPE) + 8193 * 32 + (size_t)PAST_LEN * 32;
    LAS float* qs = (LAS float*)F.lds;
    LAS float* kn = qs + 512; LAS float* vn = qs + 640; LAS float* ps = qs + 768;
    if (tid < 320) { const int hh = tid >> 5, i = tid & 31; const float c = cosT[i], s = sinT[i];
        if (hh < 8) { const float x1 = bf2f(proj[row * PLD + OFF_B_Q + hh * 64 + i]), x2 = bf2f(proj[row * PLD + OFF_B_Q + hh * 64 + 32 + i]);
            qs[hh * 64 + i] = (x1 * c - x2 * s) * 0.125f; qs[hh * 64 + 32 + i] = (x2 * c + x1 * s) * 0.125f; }
        else { const int kh = hh - 8; const float x1 = bf2f(proj[row * PLD + OFF_B_K + kh * 64 + i]), x2 = bf2f(proj[row * PLD + OFF_B_K + kh * 64 + 32 + i]);
            kn[kh * 64 + i] = x1 * c - x2 * s; kn[kh * 64 + 32 + i] = x2 * c + x1 * s; } }
    else if (tid < 448) { const int c = tid - 320; vn[c] = bf2f(proj[row * PLD + OFF_B_V + c]); }
    lds_barrier();
    const float* ck = F.cache_k + (size_t)b * WINDOW * 128; const float* cv = F.cache_v + (size_t)b * WINDOW * 128;
    {
        float* ko = F.out + O_KS + (size_t)b * WINDOW * 128; float* vo = F.out + O_VS + (size_t)b * WINDOW * 128;
#pragma unroll
        for (int u = 0; u < 8; ++u) { const int idx = (tid + 512 * u) * 4, wrow = idx >> 7, c = idx & 127;
            f32x4 kvv, vvv;
            if (wrow < WINDOW - 1) { kvv = *(const f32x4*)(ck + (size_t)(wrow + 1) * 128 + c); vvv = *(const f32x4*)(cv + (size_t)(wrow + 1) * 128 + c); }
            else { kvv = *(const LAS f32x4*)&kn[c]; vvv = *(const LAS f32x4*)&vn[c]; }
            *(f32x4*)(ko + idx) = kvv; *(f32x4*)(vo + idx) = vvv; }
    }
    const int hh = w, kvh = w >> 2;
    float sc[3]; float mx = F.sinks[hh];
    const float sink = mx;
#pragma unroll
    for (int i = 0; i < 3; ++i) {
        const int j = lane + 64 * i; sc[i] = -INFINITY;
        if (j <= WINDOW) {
            float a = 0.f;
            if (j < WINDOW) { const float* kp = ck + (size_t)j * 128 + kvh * 64;
#pragma unroll
                for (int d = 0; d < 64; d += 4) { const f32x4 kk = *(const f32x4*)(kp + d); const f32x4 qq = *(const LAS f32x4*)&qs[hh * 64 + d]; a += kk.x * qq.x + kk.y * qq.y + kk.z * qq.z + kk.w * qq.w; } }
            else {
#pragma unroll
                for (int d = 0; d < 64; ++d) a = fmaf(kn[kvh * 64 + d], qs[hh * 64 + d], a); }
            sc[i] = a; mx = fmaxf(mx, a);
        }
    }
#pragma unroll
    for (int o = 32; o > 0; o >>= 1) mx = fmaxf(mx, __shfl_xor(mx, o));
    float sum = 0.f;
#pragma unroll
    for (int i = 0; i < 3; ++i) { const int j = lane + 64 * i; if (j <= WINDOW) { const float p = __expf(sc[i] - mx); ps[hh * 132 + j] = p; sum += p; } }
    sum = wave_sum(sum) + __expf(sink - mx);
    asm volatile("s_waitcnt lgkmcnt(0)" ::: "memory");
    float acc = 0.f;
    for (int j = 0; j < WINDOW; ++j) acc = fmaf(ps[hh * 132 + j], cv[(size_t)j * 128 + kvh * 64 + lane], acc);
    acc = fmaf(ps[hh * 132 + WINDOW], vn[kvh * 64 + lane], acc);
    const float z = bf2f(proj[row * PLD + OFF_B_Z + hh * 64 + lane]);
    ((bf16_t*)(F.ws + WS_H))[row * 1024 + 512 + hh * 64 + lane] = f2bf(acc / sum * siluf(z));
    wg_barrier();
}
__device__ __forceinline__ void ln_rows(Frame& F, const float* pre) {
    const float* mod = (const float*)(F.ws + WS_MOD);
    const int gw = F.vcu * NWAVES + F.wave, NGW = F.G * NWAVES;
    for (int row = gw; row < MT; row += NGW) {
        const float* xr = row < MP ? F.x_prompt + (size_t)row * 1024 : F.x_sample + (size_t)(row - MP) * 1024;
        const float* gate = mod + (size_t)(row < MP ? (row >> 13) : 2 + row - MP) * 3072 + 2048;
        f32x4 v[4]; float s = 0.f;
#pragma unroll
        for (int j = 0; j < 4; ++j) { const int c = 4 * F.lane + 256 * j; const f32x4 xv = *(const f32x4*)(xr + c), gv = *(const f32x4*)(gate + c), pv = *(const f32x4*)(pre + (size_t)row * 1024 + c);
            v[j] = xv * DEEPNORM_ALPHA + (gv + 1.0f) * pv; s += (v[j].x + v[j].y) + (v[j].z + v[j].w); }
        const float mean = wave_sum(s) * (1.f / 1024.f); float q = 0.f;
#pragma unroll
        for (int j = 0; j < 4; ++j) { v[j] = v[j] - mean; q += (v[j].x * v[j].x + v[j].y * v[j].y) + (v[j].z * v[j].z + v[j].w * v[j].w); }
        const float rstd = rsqrtf(wave_sum(q) * (1.f / 1024.f) + LN_EPS);
        float* y = F.out + O_YP + (size_t)row * 1024;
#pragma unroll
        for (int j = 0; j < 4; ++j) { const int c = 4 * F.lane + 256 * j; const f32x4 gg = *(const f32x4*)(F.ln_g + c), bb = *(const f32x4*)(F.ln_b + c); *(f32x4*)(y + c) = v[j] * rstd * gg + bb; }
    }
}
__global__ void __launch_bounds__(NWAVES * 64, 2) mega(Args args) {
    extern __shared__ __attribute__((aligned(16))) unsigned char lds_raw[];
    Frame F;
    F.lds = (LAS unsigned char*)lds_raw;
    F.MISC = (volatile LAS unsigned*)(F.lds + MISC_OFF);
    F.tid = threadIdx.x; F.lane = F.tid & 63; F.wave = __builtin_amdgcn_readfirstlane(F.tid >> 6);
    F.G = gridDim.x; { const int bx = blockIdx.x; F.vcu = (F.G % 8 == 0) ? (bx % 8) * (F.G / 8) + bx / 8 : bx; }
    F.ws = args.ws; F.out = args.out; F.ctl = (unsigned*)(args.ws + WS_CTL);
    F.x_prompt = args.in[0]; F.x_sample = args.in[1]; F.state_conv = args.in[2]; F.state_delta = args.in[3]; F.cache_k = args.in[4]; F.cache_v = args.in[5];
    F.c_prompt = args.in[6]; F.c_sample = args.in[7]; F.w_ada = args.in[8]; F.b_ada = args.in[9]; F.w_in = args.in[10]; F.conv_w = args.in[11];
    F.a_log = args.in[12]; F.dt_bias = args.in[13]; F.norm_a = args.in[14]; F.sinks = args.in[15]; F.w_out = args.in[16]; F.ln_g = args.in[17]; F.ln_b = args.in[18];
    for (int u = F.tid; u < (LDS_BYTES - LDSCTL_OFF) / 4; u += NWAVES * 64) ((LAS unsigned*)(F.lds + LDSCTL_OFF))[u] = 0u;
    __syncthreads();
    const int lo = args.ph_lo, hi = args.ph_hi;
    XcdBarrier bar; bar.bar = F.ctl + CW_BAR; bar.x = 0; bar.st = nullptr;
    if (hi - lo > 1) bar = xcd_barrier_post(F.ctl + CW_BAR, F.MISC + 8);
#define IN(k) (lo <= (k) && (k) < hi)
#define SEAM(k) do { if (IN(k) && IN((k) + 1)) xcd_barrier(bar); } while (0)
    if (IN(0)) { p0_prologue(F); } SEAM(0);
    if (IN(1)) { p1_h(F); } SEAM(1);
    if (IN(2)) {
        pg8::Gemm g{(const pg8::bf16_t*)(F.ws + WS_H), (const pg8::bf16_t*)(F.ws + WS_WIN), MPAD, PLD, 1024}; pg8::StaticOrder S; S.init(MPAD, PLD, F.G, (int)blockIdx.x);
        pg8::EpiBf16<0> E{(pg8::bf16_t*)(F.ws + WS_PROJ), PLD, nullptr, 0, 0, 1.f};
        pg8::gemm_phase<pg8::EpiBf16<0>, pg8::StaticOrder, true, true>(F.lds, g, S, E);
    } SEAM(2);
    if (IN(3)) { for (int it = F.vcu; it < 1024; it += F.G) e1_item(F, it); } SEAM(3);
    if (IN(4)) { if (blockIdx.x < 64) scan_unit(F, (int)blockIdx.x & 7, (int)blockIdx.x >> 3);
                 else { const int nb = F.G - 64, id = (int)blockIdx.x - 64;
                        for (int it = id; it < 256; it += nb) swa_item(F, it);
                        for (int it = (id + 128) % nb; it < 512; it += nb) sd_item(F, it);
                        for (int it = (id + 64) % nb; it < 128; it += nb) ss_item(F, it); } } SEAM(4);
    if (IN(5)) { for (int it = F.vcu; it < 1024; it += F.G) o_item(F, it); } SEAM(5);
    if (IN(6)) {
        pg8::Gemm g{(const pg8::bf16_t*)(F.ws + WS_H), (const pg8::bf16_t*)(F.ws + WS_WOUT), MPAD, 1024, 1024}; pg8::StaticOrder S; S.init(MPAD, 1024, F.G, (int)blockIdx.x);
        pg8::EpiF32 E{(float*)(F.ws + WS_X), 1024, nullptr};
        pg8::gemm_phase<pg8::EpiF32, pg8::StaticOrder, true, true>(F.lds, g, S, E);
    } SEAM(6);
    if (IN(7)) { ln_rows(F, (const float*)(F.ws + WS_X)); }
#undef IN
#undef SEAM
}
extern "C" void kernel_launch(void* const* d_in, const int* in_sizes, int n_in, void* d_out, int out_size, void* d_ws, size_t ws_size, hipStream_t stream) {
    static int grid = 0;
    if (grid == 0) {
        int dev = 0, cus = 0;
        if (n_in != 19 || ws_size < WS_END || hipGetDevice(&dev) != hipSuccess || hipDeviceGetAttribute(&cus, hipDeviceAttributeMultiprocessorCount, dev) != hipSuccess) { fprintf(stderr, "kernel_launch: bad environment (n_in %d ws %zu)\n", n_in, ws_size); grid = -1; return; }
        if (hipFuncSetAttribute((const void*)mega, hipFuncAttributeMaxDynamicSharedMemorySize, LDS_BYTES) != hipSuccess) { fprintf(stderr, "kernel_launch: hipFuncSetAttribute failed\n"); grid = -1; return; }
        grid = cus;
    }
    if (grid < 0) return;
    const float* x_prompt = (const float*)d_in[0]; const float* x_sample = (const float*)d_in[1];
    const float* state_conv = (const float*)d_in[2]; const float* state_delta = (const float*)d_in[3];
    const float* cache_k = (const float*)d_in[4]; const float* cache_v = (const float*)d_in[5];
    const float* conv_w = (const float*)d_in[11]; const float* a_log = (const float*)d_in[12]; const float* dt_bias = (const float*)d_in[13];
    const float* norm_a = (const float*)d_in[14]; const float* sinks = (const float*)d_in[15];
    const float* ln_g = (const float*)d_in[17]; const float* ln_b = (const float*)d_in[18];
    float* out = (float*)d_out; unsigned char* ws = (unsigned char*)d_ws;
    (void)hipMemsetAsync(ws + WS_CTL, 0, CTL_ZERO_BYTES, stream);
    Args a{};
    for (int i = 0; i < 19; ++i) a.in[i] = (const float*)d_in[i];
    a.out = out; a.ws = ws;
    auto run = [&](int lo, int hi) { a.ph_lo = lo; a.ph_hi = hi; hipLaunchKernelGGL(mega, dim3(grid), dim3(NWAVES * 64), LDS_BYTES, stream, a); };
    for (int p = 0; p < 8; ++p) run(p, p + 1);
}
```
